# Optimizing an MI355X kernel written in HIP

```python
import jax, jax.numpy as jnp
from jax import lax
import numpy as np

D_MODEL = 2048
BATCH = 4
SEQ = 8192
DEPTH = 1
DEC_BATCH = 8
DEC_SEQ = 64
PAST_LEN = 2048

CHUNK = 64
MIX_WIDTH = D_MODEL
ATTN_WIDTH = MIX_WIDTH // 2
N_HEADS = 8
HEAD_DIM = ATTN_WIDTH // N_HEADS
IDX_HEADS = 16
IDX_DIM = 64
TOPK_MAX = 256
POOL_WIDTH = MIX_WIDTH - ATTN_WIDTH
POOL_WINDOWS = (2, 4, 8, 16)
POOL_GROUPS = len(POOL_WINDOWS)
POOL_GROUP_DIM = POOL_WIDTH // POOL_GROUPS
POOL_PAD = max(POOL_WINDOWS) - 1
D_FF = ((8 * D_MODEL + 3 * 256 - 1) // (3 * 256)) * 256
IN_SIZES = (ATTN_WIDTH, ATTN_WIDTH, ATTN_WIDTH, IDX_HEADS * IDX_DIM, IDX_DIM, IDX_HEADS, POOL_WIDTH)
IN_WIDTH = sum(IN_SIZES)
IN_SPLITS = [int(s) for s in np.cumsum(IN_SIZES)[:-1]]
Q_BLOCK = 128
NEG_INF = -1e30
EPS = 1e-6

kernel_name = "hymba_dsa_pool_stream_step"


def rmsnorm(x, g):
    x32 = x.astype(jnp.float32)
    y = x32 * lax.rsqrt(jnp.mean(x32 * x32, axis=-1, keepdims=True) + EPS) * g.astype(jnp.float32)
    return y.astype(x.dtype)


def ada_modulation(c, w_ada_l, b_ada_l):
    mod = jax.nn.silu(c) @ w_ada_l + b_ada_l
    return [m[:, None, :] for m in jnp.split(mod, 6, axis=-1)]


def split_proj(h, w_in_l):
    B, T, _ = h.shape
    p = jnp.einsum('btd,de->bte', h, w_in_l)
    q, k, v, qi, ki, wi, u = jnp.split(p, IN_SPLITS, axis=-1)
    q = q.reshape(B, T, N_HEADS, HEAD_DIM)
    k = k.reshape(B, T, N_HEADS, HEAD_DIM)
    v = v.reshape(B, T, N_HEADS, HEAD_DIM)
    qi = qi.reshape(B, T, IDX_HEADS, IDX_DIM)
    return q, k, v, qi, ki, wi, u


def dsa_attend(q, qi, wi, qpos, K, V, KI, kpos, topk):
    B, Q = q.shape[:2]
    f32 = jnp.float32
    dots = jnp.einsum('bqhd,bsd->bqhs', qi.astype(f32), KI.astype(f32)) * (IDX_DIM ** -0.5)
    score = jnp.einsum('bqh,bqhs->bqs', wi.astype(f32) * (IDX_HEADS ** -0.5), jax.nn.relu(dots))
    admissible = (kpos[None, :] // CHUNK) <= (qpos[:, None] // CHUNK)
    score = jnp.where(admissible[None], score, NEG_INF)
    top_val, top_idx = lax.top_k(score, topk)
    valid = top_val > 0.5 * NEG_INF
    Kg = jax.vmap(lambda kb, ib: kb[ib])(K, top_idx)
    Vg = jax.vmap(lambda vb, ib: vb[ib])(V, top_idx)
    logits = jnp.einsum('bqhd,bqkhd->bqhk', q.astype(f32), Kg.astype(f32)) * (HEAD_DIM ** -0.5)
    logits = jnp.where(valid[:, :, None, :], logits, NEG_INF)
    p = jax.nn.softmax(logits, axis=-1)
    o = jnp.einsum('bqhk,bqkhd->bqhd', p.astype(Vg.dtype), Vg)
    return o.reshape(B, Q, ATTN_WIDTH)


def dsa_prompt(q, k, v, qi, ki, wi, pos, topk):
    B, T = q.shape[:2]
    nb = T // Q_BLOCK

    def blockify(a):
        return jnp.moveaxis(a.reshape(a.shape[0], nb, Q_BLOCK, *a.shape[2:]), 1, 0)

    xs = (blockify(q), blockify(qi), blockify(wi), pos.reshape(nb, Q_BLOCK))
    out = lax.map(lambda blk: dsa_attend(blk[0], blk[1], blk[2], blk[3], k, v, ki, pos, topk), xs)
    return jnp.moveaxis(out, 0, 1).reshape(B, T, ATTN_WIDTH)


def pool_mixer(u, prefix, pos, w_pool_l, scale_l):
    B, T, _ = u.shape
    f32 = jnp.float32
    xp = jnp.concatenate([prefix, u], axis=1).astype(f32)
    cs = jnp.concatenate([jnp.zeros((B, 1, POOL_WIDTH), f32), jnp.cumsum(xp, axis=1)], axis=1)
    end = cs[:, POOL_PAD + 1:POOL_PAD + 1 + T]
    outs = []
    for g, w in enumerate(POOL_WINDOWS):
        sl = slice(g * POOL_GROUP_DIM, (g + 1) * POOL_GROUP_DIM)
        start = cs[:, POOL_PAD + 1 - w:POOL_PAD + 1 - w + T, sl]
        cnt = jnp.minimum(pos + 1, w).astype(f32)[None, :, None]
        outs.append((end[..., sl] - start) / cnt - u[..., sl].astype(f32))
    z = jnp.stack(outs, axis=2)
    y = jnp.einsum('btgc,gce->btge', z, w_pool_l.astype(f32)).reshape(B, T, POOL_WIDTH)
    return (y * scale_l.astype(f32)).astype(u.dtype)


def residual_update(x, attn_o, pool_o, mods, w_out_l, g2, w_gate_l, w_up_l, w_down_l):
    _, _, gate1, shift2, scale2, gate2 = mods
    mix = jnp.einsum('btm,md->btd', jnp.concatenate([attn_o, pool_o], axis=-1), w_out_l)
    x = x + gate1 * mix
    h2 = rmsnorm(x, g2) * (1.0 + scale2) + shift2
    ff = jax.nn.silu(h2 @ w_gate_l) * (h2 @ w_up_l)
    return x + gate2 * (ff @ w_down_l)


def setup_inputs(seed: int = 0) -> dict:
    key = jax.random.key(seed)
    ks = jax.random.split(key, 24)
    f32 = jnp.float32
    nrm = lambda k, shape, s: (jax.random.normal(k, shape, f32) * s)
    return {
        "x_prompt": nrm(ks[0], (BATCH, SEQ, D_MODEL), 1.0),
        "x_sample": nrm(ks[1], (DEC_BATCH, DEC_SEQ, D_MODEL), 1.0),
        "c_prompt": nrm(ks[2], (BATCH, D_MODEL), 1.0),
        "c_sample": nrm(ks[3], (DEC_BATCH, D_MODEL), 1.0),
        "cache_k": nrm(ks[4], (DEPTH, DEC_BATCH, PAST_LEN, N_HEADS, HEAD_DIM), 1.0),
        "cache_v": nrm(ks[5], (DEPTH, DEC_BATCH, PAST_LEN, N_HEADS, HEAD_DIM), 1.0),
        "cache_kidx": nrm(ks[6], (DEPTH, DEC_BATCH, PAST_LEN, IDX_DIM), 1.0),
        "state_pool": nrm(ks[7], (DEPTH, DEC_BATCH, POOL_PAD, POOL_WIDTH), 1.0),
        "w_ada": nrm(ks[8], (DEPTH, D_MODEL, 6 * D_MODEL), 0.3 * D_MODEL ** -0.5),
        "b_ada": nrm(ks[9], (DEPTH, 6 * D_MODEL), 0.02),
        "g_norm1": 1.0 + nrm(ks[10], (DEPTH, D_MODEL), 0.02),
        "w_in": nrm(ks[11], (DEPTH, D_MODEL, IN_WIDTH), D_MODEL ** -0.5),
        "w_pool": nrm(ks[12], (DEPTH, POOL_GROUPS, POOL_GROUP_DIM, POOL_GROUP_DIM), POOL_GROUP_DIM ** -0.5),
        "pool_scale": 1.0 + nrm(ks[13], (DEPTH, POOL_WIDTH), 0.02),
        "w_out": nrm(ks[14], (DEPTH, MIX_WIDTH, D_MODEL), MIX_WIDTH ** -0.5),
        "g_norm2": 1.0 + nrm(ks[15], (DEPTH, D_MODEL), 0.02),
        "w_gate": nrm(ks[16], (DEPTH, D_MODEL, D_FF), D_MODEL ** -0.5),
        "w_up": nrm(ks[17], (DEPTH, D_MODEL, D_FF), D_MODEL ** -0.5),
        "w_down": nrm(ks[18], (DEPTH, D_FF, D_MODEL), D_FF ** -0.5),
        "g_final": 1.0 + nrm(ks[19], (D_MODEL,), 0.02),
    }


def reference(x_prompt, x_sample, c_prompt, c_sample, cache_k, cache_v, cache_kidx, state_pool,
              w_ada, b_ada, g_norm1, w_in, w_pool, pool_scale, w_out, g_norm2, w_gate, w_up, w_down, g_final):
    B, T = x_prompt.shape[:2]
    Bs, Ts = x_sample.shape[:2]
    P = cache_k.shape[2]
    topk_p = min(TOPK_MAX, T // 4)
    topk_s = min(TOPK_MAX, (P + Ts) // 4)
    pos_p = jnp.arange(T, dtype=jnp.int32)
    pos_s = P + jnp.arange(Ts, dtype=jnp.int32)
    kpos_s = jnp.arange(P + Ts, dtype=jnp.int32)

    xp, xs = x_prompt, x_sample
    kp_l, vp_l, kip_l, pp_l = [], [], [], []
    ks_l, vs_l, kis_l, ps_l = [], [], [], []
    for l in range(DEPTH):
        mods = ada_modulation(c_prompt, w_ada[l], b_ada[l])
        h = rmsnorm(xp, g_norm1[l]) * (1.0 + mods[1]) + mods[0]
        q, k, v, qi, ki, wi, u = split_proj(h, w_in[l])
        attn_o = dsa_prompt(q, k, v, qi, ki, wi, pos_p, topk_p)
        prefix = jnp.zeros((B, POOL_PAD, POOL_WIDTH), u.dtype)
        pool_o = pool_mixer(u, prefix, pos_p, w_pool[l], pool_scale[l])
        xp = residual_update(xp, attn_o, pool_o, mods, w_out[l], g_norm2[l], w_gate[l], w_up[l], w_down[l])
        kp_l.append(k)
        vp_l.append(v)
        kip_l.append(ki)
        pp_l.append(jnp.concatenate([prefix, u], axis=1)[:, -POOL_PAD:])

        mods_s = ada_modulation(c_sample, w_ada[l], b_ada[l])
        hs = rmsnorm(xs, g_norm1[l]) * (1.0 + mods_s[1]) + mods_s[0]
        q_s, k_s, v_s, qi_s, ki_s, wi_s, u_s = split_proj(hs, w_in[l])
        K_all = jnp.concatenate([cache_k[l], k_s], axis=1)
        V_all = jnp.concatenate([cache_v[l], v_s], axis=1)
        KI_all = jnp.concatenate([cache_kidx[l], ki_s], axis=1)
        attn_s = dsa_attend(q_s, qi_s, wi_s, pos_s, K_all, V_all, KI_all, kpos_s, topk_s)
        pool_s = pool_mixer(u_s, state_pool[l], pos_s, w_pool[l], pool_scale[l])
        xs = residual_update(xs, attn_s, pool_s, mods_s, w_out[l], g_norm2[l], w_gate[l], w_up[l], w_down[l])
        ks_l.append(k_s)
        vs_l.append(v_s)
        kis_l.append(ki_s)
        ps_l.append(jnp.concatenate([state_pool[l], u_s], axis=1)[:, -POOL_PAD:])

    y_prompt = rmsnorm(xp, g_final)
    y_sample = rmsnorm(xs, g_final)
    return (y_prompt, y_sample,
            jnp.stack(kp_l), jnp.stack(vp_l), jnp.stack(kip_l), jnp.stack(pp_l),
            jnp.stack(ks_l), jnp.stack(vs_l), jnp.stack(kis_l), jnp.stack(ps_l))
```

```cpp
#include <hip/hip_runtime.h>
#include <hip/hip_cooperative_groups.h>
#include <cstdio>
#include <cstdint>
namespace cg = cooperative_groups;

#ifndef N_LAUNCH
#define N_LAUNCH 1
#endif
#ifndef IDX_REP_SCORE
#define IDX_REP_SCORE 1
#endif
#ifndef IDX_REP_MASK
#define IDX_REP_MASK 1
#endif
#ifndef DUP_PHASE
#define DUP_PHASE -1
#endif

#define LAS __attribute__((address_space(3)))
typedef unsigned short bf16_t;
typedef short bf16x8 __attribute__((ext_vector_type(8)));
typedef short s16x4 __attribute__((ext_vector_type(4)));
typedef float f32x2 __attribute__((ext_vector_type(2)));
typedef float f32x4 __attribute__((ext_vector_type(4)));
typedef float f32x16 __attribute__((ext_vector_type(16)));
typedef unsigned u32x2 __attribute__((ext_vector_type(2)));
typedef unsigned u32x4 __attribute__((ext_vector_type(4)));

constexpr int D = 2048, NBP = 4, SEQ = 8192, TP = NBP * SEQ, NBS = 8, DSEQ = 64, TS = NBS * DSEQ, MT = TP + TS;
constexpr int PAST = 2048, SK = PAST + DSEQ, AW = 1024, HD = 128, IDIM = 64, DFF = 5632, NIN = 5200, NINP = 5376;
constexpr int MODW = 6 * D;
constexpr int NTHREADS = 512, NWAVES = 8;
constexpr size_t O_KP = (size_t)MT * D;
constexpr size_t O_VP = O_KP + (size_t)TP * AW;
constexpr size_t O_KIP = O_VP + (size_t)TP * AW;
constexpr size_t O_PP = O_KIP + (size_t)TP * IDIM;
constexpr size_t O_KS = O_PP + (size_t)NBP * 15 * 1024;
constexpr size_t O_VS = O_KS + (size_t)TS * AW;
constexpr size_t O_KIS = O_VS + (size_t)TS * AW;
constexpr size_t O_PS = O_KIS + (size_t)TS * IDIM;
constexpr size_t O_END = O_PS + (size_t)NBS * 15 * 1024;
constexpr size_t MiB = 1u << 20;
constexpr size_t WS_MODS = 1 * MiB, WS_WIN = 2 * MiB, WS_WOUT = 23 * MiB, WS_WGU = 31 * MiB, WS_WDN = 75 * MiB, WS_WPOOL = 97 * MiB;
constexpr size_t WS_KIP = 98 * MiB, WS_KIS = 102 * MiB, WS_WI = 105 * MiB, WS_MASKP = 108 * MiB, WS_MASKS = 140 * MiB;
constexpr size_t WS_QB = 141 * MiB, WS_QIB = 206 * MiB, WS_KP = 271 * MiB, WS_VP = 335 * MiB, WS_KS = 399 * MiB, WS_VS = 432 * MiB;
constexpr size_t WS_PART1 = 500 * MiB, WS_PART2 = 540 * MiB;
constexpr size_t WS_U = 465 * MiB, WS_Z = 595 * MiB, WS_H = 660 * MiB, WS_MIX = 790 * MiB, WS_ACT = 141 * MiB, WS_END = 920 * MiB;
static_assert(WS_ACT + (size_t)MT * DFF * 2 <= WS_PART1 && WS_PART1 + (size_t)8 * TS * D * 4 <= WS_PART2 && WS_PART2 + (size_t)11 * TS * D * 4 <= WS_Z, "ACT overlay / partials");
constexpr int LDS_BYTES = 139264 + 64;

struct Params {
    const float *xp, *xs, *cp, *cs, *ck, *cv, *cki, *sp, *wada, *bada, *g1, *win, *wpool, *pscale, *wout, *g2, *wgate, *wup, *wdown, *gf;
    float* out; unsigned char* ws; int lo, hi;
};

__device__ __forceinline__ int rfl(int v) { return __builtin_amdgcn_readfirstlane(v); }
__device__ __forceinline__ unsigned cvt_pk_bf16(float lo, float hi) { unsigned r; asm volatile("v_cvt_pk_bf16_f32 %0, %1, %2" : "=v"(r) : "v"(lo), "v"(hi)); return r; }
__device__ __forceinline__ u32x4 pack8(f32x4 a, f32x4 b) { u32x4 w; w.x = cvt_pk_bf16(a[0], a[1]); w.y = cvt_pk_bf16(a[2], a[3]); w.z = cvt_pk_bf16(b[0], b[1]); w.w = cvt_pk_bf16(b[2], b[3]); return w; }
__device__ __forceinline__ u32x2 pack4(f32x4 a) { u32x2 w; w.x = cvt_pk_bf16(a[0], a[1]); w.y = cvt_pk_bf16(a[2], a[3]); return w; }
__device__ __forceinline__ float wave_sum(float v) {
#pragma unroll
    for (int o = 1; o < 64; o <<= 1) v += __shfl_xor(v, o);
    return v;
}
__device__ __forceinline__ int snake(int it, int G, int c) { return it * G + ((it & 1) ? (G - 1 - c) : c); }
__device__ __forceinline__ int modrow(int r) { return r < TP ? (r >> 13) : 4 + ((r - TP) >> 6); }

namespace pg8 {
constexpr int BM = 256, BK = 64, HALF = 128, HTB = HALF * BK * 2, STAGE_BYTES = 8 * HTB, NXCD = 8, WGM = 8;
__host__ __device__ __forceinline__ int lds_byte(int r, int c) { const int st = (r >> 4) * 2 + (c >> 5), rr = r & 15, cc = c & 31, ob = rr * 64 + cc * 2; return st * 1024 + (ob ^ (((ob >> 9) & 1) << 5)); }
__host__ __device__ __forceinline__ void stage_rc(int b, int& R, int& C) { const int st = b / 1024, sb = b % 1024, swz = sb ^ (((sb >> 9) & 1) << 5); R = (st >> 1) * 16 + swz / 64; C = (st & 1) * 32 + (swz % 64) / 2; }
__host__ __device__ __forceinline__ int perm32(int rho) { const int n = rho >> 4, i = rho & 15; return 8 * (i >> 2) + 4 * n + (i & 3); }
struct Unit { int pm, pn; };
struct Gemm { const bf16_t* A; const bf16_t* Bt; int M, N, K, lda, ldb; size_t a_pn_step; int ks_shift; size_t ks_bytes; };
struct StaticOrder {
    int nM, nN, nwg, G, c;
    __host__ __device__ void init(int M, int N, int G_, int c_) { nM = M / BM; nN = N / BM; nwg = nM * nN; G = G_; c = c_; }
    __host__ __device__ bool next(int i, Unit& u) const {
        const long L = (long)i * G + c; if (L >= nwg) return false;
        int wgid = (int)L; { const int q = nwg / NXCD, r = nwg % NXCD, xcd = wgid % NXCD, off = wgid / NXCD; wgid = (xcd < r ? xcd * (q + 1) : r * (q + 1) + (xcd - r) * q) + off; }
        const int nig = WGM * nN, gid = wgid / nig, fm = gid * WGM, gsz = (nM - fm) < WGM ? (nM - fm) : WGM;
        u.pm = fm + ((wgid % nig) % gsz); u.pn = (wgid % nig) / gsz; return true;
    }
};
template <class Epi, bool ALIGN_EPI = true>
__device__ __forceinline__ void gemm_phase(LAS unsigned char* lds, const Gemm g, const StaticOrder& S, const Epi& E) {
    const int tid = threadIdx.x, wid = __builtin_amdgcn_readfirstlane(tid >> 6), lane = tid & 63, wr = wid >> 2, wc = wid & 3, fr = lane & 15, fq = lane >> 4;
    const int K = g.K, nt = K / BK;
    unsigned voffA[2], voffB[2];
#pragma unroll
    for (int i = 0; i < 2; ++i) { int R, C; stage_rc(tid * 16 + i * 8192, R, C); const int Rb = (R & ~31) + perm32(R & 31);
        voffA[i] = (unsigned)(R * g.lda + C) * 2u; voffB[i] = (unsigned)(Rb * g.ldb + C) * 2u; }
    const size_t kstep = (size_t)(BK * 2);
    const size_t hstepA = (size_t)HALF * g.lda * 2, hstepB = (size_t)HALF * g.ldb * 2;
    const size_t tstepA = 2 * hstepA, tstepB = 2 * hstepB;
    const unsigned ldsw = (unsigned)wid * 1024u;
    const int aoff = lds_byte(wr * 64 + fr, fq * 8), boff = lds_byte(wc * 32 + fr, fq * 8);
#define PG8_SA(b, h) (((b) * 2 + (h)) * HTB)
#define PG8_SB(b, h) ((4 + (b) * 2 + (h)) * HTB)
#define PG8_STAGE(bufoff, gbase, voff) do { _Pragma("unroll") for (int _i = 0; _i < 2; ++_i) \
        __builtin_amdgcn_global_load_lds((const unsigned*)((const char*)(gbase) + (voff)[_i]), (LAS unsigned*)(lds + (bufoff) + ldsw + _i * 8192), 16, 0, 0); } while (0)
#define PG8_LDA(dst, b, h) do { _Pragma("unroll") for (int m = 0; m < 4; ++m) _Pragma("unroll") for (int k = 0; k < 2; ++k) dst[m][k] = *(const LAS bf16x8*)(lds + PG8_SA(b, h) + aoff + m * 2048 + k * 1024); } while (0)
#define PG8_LDB(dst, b, h) do { _Pragma("unroll") for (int n = 0; n < 2; ++n) _Pragma("unroll") for (int k = 0; k < 2; ++k) dst[n][k] = *(const LAS bf16x8*)(lds + PG8_SB(b, h) + boff + n * 2048 + k * 1024); } while (0)
#define PG8_MMA(ai, bj, At, Bt) do { __builtin_amdgcn_s_setprio(1); _Pragma("unroll") for (int m = 0; m < 4; ++m) _Pragma("unroll") for (int n = 0; n < 2; ++n) _Pragma("unroll") for (int k = 0; k < 2; ++k) \
        acc[ai][bj][m][n] = __builtin_amdgcn_mfma_f32_16x16x32_bf16(Bt[n][k], At[m][k], acc[ai][bj][m][n], 0, 0, 0); __builtin_amdgcn_s_setprio(0); } while (0)
#define PG8_WAIT_V(n) asm volatile("s_waitcnt vmcnt(" #n ")" ::: "memory")
#define PG8_WAIT_L(n) asm volatile("s_waitcnt lgkmcnt(" #n ")" ::: "memory")
#define PG8_BAR __builtin_amdgcn_s_barrier()
#define PG8_SCHED __builtin_amdgcn_sched_barrier(0)
    Unit cur, nxt; int ui = 0;
    if (!S.next(0, cur)) return;
    f32x4 acc[2][2][4][2];
#pragma unroll
    for (int a = 0; a < 2; ++a)
#pragma unroll
        for (int b = 0; b < 2; ++b)
#pragma unroll
            for (int m = 0; m < 4; ++m)
#pragma unroll
                for (int n = 0; n < 2; ++n) acc[a][b][m][n] = (f32x4){0.f, 0.f, 0.f, 0.f};
    bf16x8 At[4][2], B0[2][2], B1[2][2];
    const int ksm = (1 << g.ks_shift) - 1;
    const char* cA = (const char*)g.A + (size_t)cur.pm * tstepA + (size_t)cur.pn * g.a_pn_step + (size_t)(cur.pn >> g.ks_shift) * g.ks_bytes; const char* cB = (const char*)g.Bt + (size_t)(cur.pn & ksm) * tstepB + (size_t)(cur.pn >> g.ks_shift) * g.ks_bytes;
    PG8_STAGE(PG8_SB(0, 0), cB, voffB); PG8_STAGE(PG8_SB(0, 1), cB + hstepB, voffB); PG8_STAGE(PG8_SA(0, 0), cA, voffA); PG8_STAGE(PG8_SA(0, 1), cA + hstepA, voffA);
    if (wr == 1) PG8_BAR;
    PG8_WAIT_V(2); PG8_BAR;
    PG8_STAGE(PG8_SB(1, 0), cB + kstep, voffB); PG8_STAGE(PG8_SA(1, 0), cA + kstep, voffA); PG8_STAGE(PG8_SB(1, 1), cB + hstepB + kstep, voffB);
    PG8_WAIT_V(6); PG8_BAR;
    for (;;) {
        const bool has_next = S.next(ui + 1, nxt);
        const char* nA = has_next ? (const char*)g.A + (size_t)nxt.pm * tstepA + (size_t)nxt.pn * g.a_pn_step + (size_t)(nxt.pn >> g.ks_shift) * g.ks_bytes : cA; const char* nB = has_next ? (const char*)g.Bt + (size_t)(nxt.pn & ksm) * tstepB + (size_t)(nxt.pn >> g.ks_shift) * g.ks_bytes : cB;
#pragma unroll 1
        for (int t = 0; t < nt; t += 2) {
            const bool last = (t == nt - 2);
            const char* a1 = cA + (size_t)(t + 1) * kstep;
            const char* a2 = last ? nA : cA + (size_t)(t + 2) * kstep; const char* b2 = last ? nB : cB + (size_t)(t + 2) * kstep;
            const char* a3 = a2 + kstep; const char* b3 = b2 + kstep;
            PG8_LDB(B0, 0, 0); PG8_LDB(B1, 0, 1); PG8_SCHED; PG8_LDA(At, 0, 0); PG8_STAGE(PG8_SA(1, 1), a1 + hstepA, voffA);
            PG8_WAIT_V(8); PG8_WAIT_L(0); PG8_BAR; PG8_MMA(0, 0, At, B0); PG8_MMA(0, 1, At, B1); PG8_BAR; PG8_SCHED;
            PG8_LDA(At, 0, 1); PG8_STAGE(PG8_SB(0, 0), b2, voffB); PG8_STAGE(PG8_SB(0, 1), b2 + hstepB, voffB); PG8_STAGE(PG8_SA(0, 0), a2, voffA);
            PG8_WAIT_V(8); PG8_WAIT_L(0); PG8_BAR; PG8_MMA(1, 0, At, B0); PG8_MMA(1, 1, At, B1); PG8_BAR; PG8_SCHED;
            PG8_LDB(B0, 1, 0); PG8_LDB(B1, 1, 1); PG8_SCHED; PG8_LDA(At, 1, 0); PG8_STAGE(PG8_SA(0, 1), a2 + hstepA, voffA);
            PG8_WAIT_V(8); PG8_WAIT_L(0); PG8_BAR; PG8_MMA(0, 0, At, B0); PG8_MMA(0, 1, At, B1); PG8_BAR; PG8_SCHED;
            PG8_LDA(At, 1, 1); PG8_STAGE(PG8_SB(1, 0), b3, voffB); PG8_STAGE(PG8_SB(1, 1), b3 + hstepB, voffB); PG8_STAGE(PG8_SA(1, 0), a3, voffA);
            PG8_WAIT_V(8); PG8_WAIT_L(0); PG8_BAR; PG8_MMA(1, 0, At, B0); PG8_MMA(1, 1, At, B1); PG8_BAR; PG8_SCHED;
        }
        if (ALIGN_EPI) { if (wr == 0) PG8_BAR; }
        E(acc, cur, wr, wc, fr, fq);
        if (!has_next) break;
#pragma unroll
        for (int a = 0; a < 2; ++a)
#pragma unroll
            for (int b = 0; b < 2; ++b)
#pragma unroll
                for (int m = 0; m < 4; ++m)
#pragma unroll
                    for (int n = 0; n < 2; ++n) acc[a][b][m][n] = (f32x4){0.f, 0.f, 0.f, 0.f};
        cur = nxt; cA = nA; cB = nB; ++ui;
        if (ALIGN_EPI) { if (wr == 1) PG8_BAR; }
    }
    PG8_WAIT_V(0);
    if (!ALIGN_EPI) { if (wr == 0) PG8_BAR; }
    PG8_BAR;
#undef PG8_SA
#undef PG8_SB
#undef PG8_STAGE
#undef PG8_LDA
#undef PG8_LDB
#undef PG8_MMA
#undef PG8_WAIT_V
#undef PG8_WAIT_L
#undef PG8_BAR
#undef PG8_SCHED
}
}
typedef f32x4 AccT[2][2][4][2];

constexpr float QSCL = 0.08838834764831845f * 1.4426950408889634f;
struct EpiIn {
    bf16_t *QB, *QIB, *KP, *VP, *KS, *VS, *KIP, *KIS, *U; float *WI, *out;
    __device__ __forceinline__ void operator()(const AccT& acc, const pg8::Unit& u, int wr, int wc, int fr, int fq) const {
        const int pn = u.pn, sec = pn >> 2; const bool samp = u.pm >= 128;
        const int cl = (pn & 3) * 256 + wc * 32 + 8 * fq;
#pragma unroll
        for (int ai = 0; ai < 2; ++ai)
#pragma unroll
            for (int m = 0; m < 4; ++m) {
                const int r = u.pm * 256 + ai * 128 + wr * 64 + m * 16 + fr;
                const int rs = r - TP, bs = rs >> 6, ts = rs & 63;
#pragma unroll
                for (int bj = 0; bj < 2; ++bj) {
                    const int c = cl + bj * 128; const f32x4 v0 = acc[ai][bj][m][0], v1 = acc[ai][bj][m][1];
                    if (sec == 0) { *(u32x4*)(QB + (size_t)r * 1024 + c) = pack8(v0 * QSCL, v1 * QSCL); }
                    else if (sec == 3) { *(u32x4*)(QIB + (size_t)r * 1024 + c) = pack8(v0, v1); }
                    else if (sec == 1 || sec == 2) {
                        bf16_t* bb; float* fo;
                        if (!samp) { bb = (sec == 1 ? KP : VP) + (size_t)r * 1024 + c; fo = out + (sec == 1 ? O_KP : O_VP) + (size_t)r * 1024 + c; }
                        else { bb = (sec == 1 ? KS : VS) + (size_t)(bs * SK + PAST + ts) * 1024 + c; fo = out + (sec == 1 ? O_KS : O_VS) + (size_t)rs * 1024 + c; }
                        *(u32x4*)bb = pack8(v0, v1); __builtin_nontemporal_store(v0, (f32x4*)fo); __builtin_nontemporal_store(v1, (f32x4*)(fo + 4));
                    } else if (sec == 4) {
                        *(u32x4*)(U + (size_t)r * 1024 + c) = pack8(v0, v1);
                        if (!samp) { const int t = r & (SEQ - 1); if (t >= SEQ - 15) { float* po = out + O_PP + (size_t)((r >> 13) * 15 + (t - (SEQ - 15))) * 1024 + c; __builtin_nontemporal_store(v0, (f32x4*)po); __builtin_nontemporal_store(v1, (f32x4*)(po + 4)); } }
                        else if (ts >= DSEQ - 15) { float* po = out + O_PS + (size_t)(bs * 15 + (ts - (DSEQ - 15))) * 1024 + c; __builtin_nontemporal_store(v0, (f32x4*)po); __builtin_nontemporal_store(v1, (f32x4*)(po + 4)); }
                    } else {
                        if (c < 64) {
                            bf16_t* bb; float* fo;
                            if (!samp) { const int key = r & (SEQ - 1); bb = KIP + (size_t)(r >> 13) * SEQ * 64 + (size_t)(((key >> 5) * 8 + (c >> 3)) * 32 + (key & 31)) * 8; fo = out + O_KIP + (size_t)r * 64 + c; }
                            else { const int key = PAST + ts; bb = KIS + (size_t)bs * SK * 64 + (size_t)(((key >> 5) * 8 + (c >> 3)) * 32 + (key & 31)) * 8; fo = out + O_KIS + (size_t)rs * 64 + c; }
                            *(u32x4*)bb = pack8(v0, v1); __builtin_nontemporal_store(v0, (f32x4*)fo); __builtin_nontemporal_store(v1, (f32x4*)(fo + 4));
                        } else if (c < 80) {
                            float* wo = WI + (size_t)r * 16 + (c - 64); *(f32x4*)wo = v0 * 0.03125f; *(f32x4*)(wo + 4) = v1 * 0.03125f;
                        }
                    }
                }
            }
    }
};
struct EpiPool {
    bf16_t* MIX; const float* pscale;
    __device__ __forceinline__ void operator()(const AccT& acc, const pg8::Unit& u, int wr, int wc, int fr, int fq) const {
        const int c0 = u.pn * 256 + wc * 32 + 8 * fq;
#pragma unroll
        for (int bj = 0; bj < 2; ++bj) { const int c = c0 + bj * 128; const f32x4 s0 = *(const f32x4*)(pscale + c), s1 = *(const f32x4*)(pscale + c + 4);
#pragma unroll
            for (int ai = 0; ai < 2; ++ai)
#pragma unroll
                for (int m = 0; m < 4; ++m) { const int r = u.pm * 256 + ai * 128 + wr * 64 + m * 16 + fr;
                    *(u32x4*)(MIX + (size_t)r * 2048 + 1024 + c) = pack8(acc[ai][bj][m][0] * s0, acc[ai][bj][m][1] * s1); } }
    }
};
template <int WHICH>
struct EpiRes {
    const float *xp, *xs, *mods; float* Y;
    __device__ __forceinline__ void operator()(const AccT& acc, const pg8::Unit& u, int wr, int wc, int fr, int fq) const {
        const int c0 = u.pn * 256 + wc * 32 + 8 * fq;
#pragma unroll
        for (int ai = 0; ai < 2; ++ai) {
            const int rb = u.pm * 256 + ai * 128 + wr * 64; const float* gp = mods + (size_t)modrow(rb) * MODW + (WHICH == 0 ? 2 * D : 5 * D);
#pragma unroll
            for (int bj = 0; bj < 2; ++bj) { const int c = c0 + bj * 128; const f32x4 g0 = *(const f32x4*)(gp + c), g1 = *(const f32x4*)(gp + c + 4);
#pragma unroll
                for (int m = 0; m < 4; ++m) { const int r = rb + m * 16 + fr;
                    const float* src = WHICH == 0 ? (r < TP ? xp + (size_t)r * D : xs + (size_t)(r - TP) * D) : Y + (size_t)r * D;
                    const f32x4 a0 = *(const f32x4*)(src + c), a1 = *(const f32x4*)(src + c + 4);
                    float* dst = Y + (size_t)r * D + c; *(f32x4*)dst = a0 + g0 * acc[ai][bj][m][0]; *(f32x4*)(dst + 4) = a1 + g1 * acc[ai][bj][m][1]; } }
        }
    }
};
struct EpiPart {
    float* PART;
    __device__ __forceinline__ void operator()(const AccT& acc, const pg8::Unit& u, int wr, int wc, int fr, int fq) const {
        const int slice = u.pn >> 3, c0 = (u.pn & 7) * 256 + wc * 32 + 8 * fq;
#pragma unroll
        for (int ai = 0; ai < 2; ++ai)
#pragma unroll
            for (int m = 0; m < 4; ++m) { const int r = u.pm * 256 + ai * 128 + wr * 64 + m * 16 + fr;
#pragma unroll
                for (int bj = 0; bj < 2; ++bj) { float* dst = PART + ((size_t)slice * TS + r) * D + c0 + bj * 128; *(f32x4*)dst = acc[ai][bj][m][0]; *(f32x4*)(dst + 4) = acc[ai][bj][m][1]; } }
    }
};
struct EpiGU {
    bf16_t* ACT;
    __device__ __forceinline__ void operator()(const AccT& acc, const pg8::Unit& u, int wr, int wc, int fr, int fq) const {
        const int c = u.pn * 128 + wc * 32 + 8 * fq;
#pragma unroll
        for (int ai = 0; ai < 2; ++ai)
#pragma unroll
            for (int m = 0; m < 4; ++m) { const int r = u.pm * 256 + ai * 128 + wr * 64 + m * 16 + fr; f32x4 o[2];
#pragma unroll
                for (int n = 0; n < 2; ++n) { const f32x4 gt = acc[ai][0][m][n], up = acc[ai][1][m][n];
#pragma unroll
                    for (int e = 0; e < 4; ++e) o[n][e] = gt[e] * __builtin_amdgcn_rcpf(1.0f + __builtin_amdgcn_exp2f(-1.44269504f * gt[e])) * up[e]; }
                *(u32x4*)(ACT + (size_t)r * DFF + c) = pack8(o[0], o[1]); }
    }
};

__device__ __forceinline__ int inmap(int n) { return n < 4096 ? n : (n < 4160 ? 5120 + (n - 4096) : (n < 4176 ? 5184 + (n - 4160) : 4096 + (n - 4176))); }
template <int MAP>
__device__ __forceinline__ void tr_item(const float* W, int K, int N, bf16_t* WT, int row_off, LAS float* scr, int item, int lane) {
    const int nblk = (N + 31) / 32, kb = item / nblk, nb = item % nblk, k0 = 64 * kb, n0 = 32 * nb;
    const int nsrc = n0 + (lane & 31);
    float tv[32];
#pragma unroll
    for (int i = 0; i < 32; ++i) { const int kk = 2 * i + (lane >> 5); tv[i] = nsrc < N ? W[(size_t)(k0 + kk) * N + nsrc] : 0.f; }
#pragma unroll
    for (int i = 0; i < 32; ++i) { const int kk = 2 * i + (lane >> 5); scr[kk * 33 + (lane & 31)] = tv[i]; }
    asm volatile("s_waitcnt lgkmcnt(0)" ::: "memory");
    const int c = lane & 7;
#pragma unroll
    for (int j = 0; j < 4; ++j) { const int nl = (lane >> 3) + 8 * j, n = n0 + nl; const LAS float* s = scr + (8 * c) * 33 + nl;
        u32x4 o; o.x = cvt_pk_bf16(s[0 * 33], s[1 * 33]); o.y = cvt_pk_bf16(s[2 * 33], s[3 * 33]); o.z = cvt_pk_bf16(s[4 * 33], s[5 * 33]); o.w = cvt_pk_bf16(s[6 * 33], s[7 * 33]);
        if (n < N) { int dr; if (MAP == 0) dr = row_off + n; else if (MAP == 1) dr = inmap(n); else dr = 256 * (n >> 7) + (n & 127) + (MAP == 3 ? 128 : 0);
            *(u32x4*)(WT + (size_t)dr * K + k0 + 8 * c) = o; } }
    asm volatile("s_waitcnt lgkmcnt(0)" ::: "memory");
}
__device__ __forceinline__ void cvt_cache(const float* src, bf16_t* dst, int shift, size_t n4, size_t gtid, size_t nthr) {
    for (size_t i0 = gtid; i0 < n4; i0 += 8 * nthr) {
        f32x4 v[8];
#pragma unroll
        for (int u = 0; u < 8; ++u) { const size_t i = i0 + u * nthr; v[u] = (f32x4){0.f, 0.f, 0.f, 0.f}; if (i < n4) v[u] = *(const f32x4*)(src + i * 4); }
#pragma unroll
        for (int u = 0; u < 8; ++u) { const size_t i = i0 + u * nthr; if (i < n4) { const size_t e = i * 4, b = e >> shift, rem = e & (((size_t)1 << shift) - 1); *(u32x2*)(dst + b * ((size_t)SK << (shift - 11)) + rem) = pack4(v[u]); } }
    }
}
__device__ __forceinline__ void mods_task(const Params& P, LAS unsigned char* lds, int task) {
    const int tid = threadIdx.x, w = rfl(tid >> 6), lane = tid & 63;
    LAS float* T = (LAS float*)lds;
    for (int idx = tid; idx < 12 * D; idx += NTHREADS) { const int b = idx >> 11, k = idx & (D - 1); const float c = b < 4 ? P.cp[b * D + k] : P.cs[(b - 4) * D + k]; T[k * 12 + b] = c / (1.0f + __expf(-c)); }
    __syncthreads();
    f32x2 acc[12];
#pragma unroll
    for (int b = 0; b < 12; ++b) acc[b] = (f32x2){0.f, 0.f};
    const float* wp = P.wada + (size_t)(256 * w) * MODW + task * 128 + 2 * lane;
#pragma unroll 16
    for (int k = 0; k < 256; ++k) { const f32x2 wv = *(const f32x2*)(wp + (size_t)k * MODW); const LAS f32x4* tp = (const LAS f32x4*)(T + (256 * w + k) * 12); const f32x4 t0 = tp[0], t1 = tp[1], t2 = tp[2];
        acc[0] += wv * t0[0]; acc[1] += wv * t0[1]; acc[2] += wv * t0[2]; acc[3] += wv * t0[3]; acc[4] += wv * t1[0]; acc[5] += wv * t1[1]; acc[6] += wv * t1[2]; acc[7] += wv * t1[3];
        acc[8] += wv * t2[0]; acc[9] += wv * t2[1]; acc[10] += wv * t2[2]; acc[11] += wv * t2[3]; }
    __syncthreads();
    LAS float* Pp = (LAS float*)lds;
#pragma unroll
    for (int b = 0; b < 12; ++b) *(LAS f32x2*)(Pp + (w * 12 + b) * 128 + 2 * lane) = acc[b];
    __syncthreads();
    float* mods = (float*)(P.ws + WS_MODS);
    for (int o = tid; o < 12 * 128; o += NTHREADS) { const int b = o >> 7, cc = o & 127; float s = P.bada[task * 128 + cc];
#pragma unroll
        for (int ww = 0; ww < 8; ++ww) s += Pp[(ww * 12 + b) * 128 + cc];
        mods[(size_t)b * MODW + task * 128 + cc] = s; }
    __syncthreads();
}
__device__ __forceinline__ void phase0(const Params& P, LAS unsigned char* lds, int G, int c) {
    const int tid = threadIdx.x, w = rfl(tid >> 6), lane = tid & 63;
    if (c < 96) mods_task(P, lds, c);
    for (int t = c; t < 96; t += G) if (t != c || c >= 96) mods_task(P, lds, t);
    LAS float* scr = (LAS float*)(lds + w * 16384);
    const int gw = c * NWAVES + w, NGW = G * NWAVES;
    bf16_t* WIN = (bf16_t*)(P.ws + WS_WIN); bf16_t* WOUT = (bf16_t*)(P.ws + WS_WOUT); bf16_t* WGU = (bf16_t*)(P.ws + WS_WGU); bf16_t* WDN = (bf16_t*)(P.ws + WS_WDN); bf16_t* WPL = (bf16_t*)(P.ws + WS_WPOOL);
    constexpr int I_IN = (D / 64) * ((NIN + 31) / 32), I_OUT = (D / 64) * (D / 32), I_G = (D / 64) * (DFF / 32), I_DN = (DFF / 64) * (D / 32), I_PL = 4 * (256 / 64) * (256 / 32);
    constexpr int NITEMS = I_IN + I_OUT + 2 * I_G + I_DN + I_PL;
    for (int it = gw; it < NITEMS; it += NGW) {
        int r = it;
        if (r < I_IN) { tr_item<1>(P.win, D, NIN, WIN, 0, scr, r, lane); continue; } r -= I_IN;
        if (r < I_OUT) { tr_item<0>(P.wout, D, D, WOUT, 0, scr, r, lane); continue; } r -= I_OUT;
        if (r < I_G) { tr_item<2>(P.wgate, D, DFF, WGU, 0, scr, r, lane); continue; } r -= I_G;
        if (r < I_G) { tr_item<3>(P.wup, D, DFF, WGU, 0, scr, r, lane); continue; } r -= I_G;
        if (r < I_DN) { tr_item<0>(P.wdown, DFF, D, WDN, 0, scr, r, lane); continue; } r -= I_DN;
        { const int gi = r / 32, ri = r % 32; tr_item<0>(P.wpool + (size_t)gi * 65536, 256, 256, WPL, gi * 256, scr, ri, lane); }
    }
    const size_t gtid = (size_t)c * NTHREADS + tid, nthr = (size_t)G * NTHREADS;
    cvt_cache(P.ck, (bf16_t*)(P.ws + WS_KS), 21, (size_t)NBS * PAST * AW / 4, gtid, nthr);
    cvt_cache(P.cv, (bf16_t*)(P.ws + WS_VS), 21, (size_t)NBS * PAST * AW / 4, gtid, nthr);
    { bf16_t* KIS = (bf16_t*)(P.ws + WS_KIS);
      for (size_t i = gtid; i < (size_t)NBS * PAST * IDIM / 4; i += nthr) { const size_t e = i * 4, b = e >> 17; const int rem = (int)(e & 131071), key = rem >> 6, dim = rem & 63;
          const f32x4 v = *(const f32x4*)(P.cki + e); *(u32x2*)(KIS + b * ((size_t)SK * 64) + (size_t)(((key >> 5) * 8 + (dim >> 3)) * 32 + (key & 31)) * 8 + (dim & 7)) = pack4(v); } }
}

template <int MODE>
__device__ __forceinline__ void norm_phase(const Params& P, int G, int c) {
    const int tid = threadIdx.x, w = rfl(tid >> 6), lane = tid & 63;
    const int gw = c * NWAVES + w, NGW = G * NWAVES;
    const float* mods = (const float*)(P.ws + WS_MODS); bf16_t* H = (bf16_t*)(P.ws + WS_H);
    const float* gsrc = MODE == 0 ? P.g1 : (MODE == 1 ? P.g2 : P.gf);
    for (int task = gw; task < TS + TP / 16; task += NGW) {
        const int r0 = task < TS ? TP + task : (task - TS) * 16, nrows = task < TS ? 1 : 16, mb = modrow(r0);
        f32x4 gs[8], sh[8];
#pragma unroll
        for (int j = 0; j < 8; ++j) { const int col = 4 * lane + 256 * j; gs[j] = *(const f32x4*)(gsrc + col);
            if (MODE < 2) { const float* mp = mods + (size_t)mb * MODW + (MODE == 0 ? 0 : 3 * D); sh[j] = *(const f32x4*)(mp + col); gs[j] = gs[j] * (1.0f + *(const f32x4*)(mp + D + col)); } }
#define NRM_SRC(r_) (MODE == 0 ? ((r_) < TP ? P.xp + (size_t)(r_) * D : P.xs + (size_t)((r_) - TP) * D) : P.out + (size_t)(r_) * D)
#define NRM_FIN(v_, r_) do { float ss = 0.f; _Pragma("unroll") for (int j = 0; j < 8; ++j) ss += (v_[j][0] * v_[j][0] + v_[j][1] * v_[j][1]) + (v_[j][2] * v_[j][2] + v_[j][3] * v_[j][3]); \
            const float rstd = 1.0f / sqrtf(wave_sum(ss) * (1.0f / D) + 1e-6f); \
            _Pragma("unroll") for (int j = 0; j < 8; ++j) { const int col = 4 * lane + 256 * j; \
                if (MODE < 2) { const f32x4 o = v_[j] * rstd * gs[j] + sh[j]; *(u32x2*)(H + (size_t)(r_) * D + col) = pack4(o); } \
                else { __builtin_nontemporal_store(v_[j] * rstd * gs[j], (f32x4*)(P.out + (size_t)(r_) * D + col)); } } } while (0)
        if (nrows == 1) {
            const int r = r0; const float* src = NRM_SRC(r);
            f32x4 v[8];
#pragma unroll
            for (int j = 0; j < 8; ++j) v[j] = *(const f32x4*)(src + 4 * lane + 256 * j);
            if (MODE >= 1) {
                constexpr int NSL = MODE == 1 ? 8 : 11; const float* part = (const float*)(P.ws + (MODE == 1 ? WS_PART1 : WS_PART2)) + (size_t)(r - TP) * D;
                const float* gp = mods + (size_t)mb * MODW + (MODE == 1 ? 2 * D : 5 * D);
                const float* xsrc = MODE == 1 ? P.xs + (size_t)(r - TP) * D : src;
#pragma unroll
                for (int j = 0; j < 8; ++j) { const int col = 4 * lane + 256 * j; f32x4 a = (f32x4){0.f, 0.f, 0.f, 0.f};
                    f32x4 pv[NSL];
#pragma unroll
                    for (int sl = 0; sl < NSL; ++sl) pv[sl] = *(const f32x4*)(part + (size_t)sl * TS * D + col);
#pragma unroll
                    for (int sl = 0; sl < NSL; ++sl) a += pv[sl];
                    v[j] = *(const f32x4*)(xsrc + col) + *(const f32x4*)(gp + col) * a;
                    if (MODE == 1) *(f32x4*)(P.out + (size_t)r * D + col) = v[j]; }
            }
            NRM_FIN(v, r);
        } else {
            for (int rr = 0; rr < 16; rr += 4) {
                const int ra = r0 + rr; const float* sa = NRM_SRC(ra); const float* sb = NRM_SRC(ra + 1); const float* sc = NRM_SRC(ra + 2); const float* sd = NRM_SRC(ra + 3);
                f32x4 va[8], vb[8], vc[8], vd[8];
#pragma unroll
                for (int j = 0; j < 8; ++j) { va[j] = *(const f32x4*)(sa + 4 * lane + 256 * j); vb[j] = *(const f32x4*)(sb + 4 * lane + 256 * j); vc[j] = *(const f32x4*)(sc + 4 * lane + 256 * j); vd[j] = *(const f32x4*)(sd + 4 * lane + 256 * j); }
                NRM_FIN(va, ra); NRM_FIN(vb, ra + 1); NRM_FIN(vc, ra + 2); NRM_FIN(vd, ra + 3);
            }
        }
#undef NRM_SRC
#undef NRM_FIN
    }
}

#define LDU(p_) ({ const u32x2 w_ = *(const u32x2*)(p_); (f32x4){__uint_as_float(w_.x << 16), __uint_as_float(w_.x & 0xffff0000u), __uint_as_float(w_.y << 16), __uint_as_float(w_.y & 0xffff0000u)}; })
template <int W>
__device__ __forceinline__ void z_task(const Params& P, const bf16_t* U, bf16_t* Z, int r0, int col, int lane) {
    constexpr int NR = 16 + W - 1;
    const bool samp = r0 >= TP; const int t0 = samp ? ((r0 - TP) & 63) : (r0 & (SEQ - 1)); const int seq0 = r0 - t0;
    const float* spre = samp ? P.sp + (size_t)((r0 - TP) >> 6) * 15 * 1024 : nullptr;
    f32x4 x[NR];
#pragma unroll
    for (int i = 0; i < NR; ++i) { const int tt = t0 - (W - 1) + i; x[i] = (f32x4){0.f, 0.f, 0.f, 0.f};
        if (tt >= 0) x[i] = LDU(U + (size_t)(seq0 + tt) * 1024 + col); else if (samp) x[i] = *(const f32x4*)(spre + (size_t)(15 + tt) * 1024 + col); }
    f32x4 sum = (f32x4){0.f, 0.f, 0.f, 0.f};
#pragma unroll
    for (int i = 0; i < W - 1; ++i) sum += x[i];
#pragma unroll
    for (int t = 0; t < 16; ++t) {
        sum += x[t + W - 1];
        const int tt = t0 + t, cnt = samp ? W : (tt + 1 < W ? tt + 1 : W);
        *(u32x2*)(Z + (size_t)(seq0 + tt) * 1024 + col) = pack4(sum * (1.0f / (float)cnt) - x[t + W - 1]);
        sum -= x[t];
    }
}
__device__ __forceinline__ void z_phase(const Params& P, int G, int c) {
    const int tid = threadIdx.x, w = rfl(tid >> 6), lane = tid & 63;
    const int gw = c * NWAVES + w, NGW = G * NWAVES;
    const bf16_t* U = (const bf16_t*)(P.ws + WS_U); bf16_t* Z = (bf16_t*)(P.ws + WS_Z);
    for (int task = gw; task < (MT / 16) * 4; task += NGW) {
        const int grp = task & 3, r0 = (task >> 2) * 16, col = grp * 256 + 4 * lane;
        if (grp == 0) z_task<2>(P, U, Z, r0, col, lane); else if (grp == 1) z_task<4>(P, U, Z, r0, col, lane); else if (grp == 2) z_task<8>(P, U, Z, r0, col, lane); else z_task<16>(P, U, Z, r0, col, lane);
    }
}

__device__ __forceinline__ unsigned fkey(float f) { const unsigned u = __float_as_uint(f); return u ^ ((u >> 31) ? 0xFFFFFFFFu : 0x80000000u); }
#ifndef IDX_SELFCHECK
#define IDX_SELFCHECK 0
#endif
#ifndef IDX_FORCE_SLOW
#define IDX_FORCE_SLOW 0
#endif
constexpr int LCAP = 384;
constexpr int NIDX_UNITS = 1024 + 16, HQW = 1088;
__device__ __forceinline__ void hscan(const LAS unsigned* h, unsigned krem, int lane, int& digit, unsigned& above, unsigned& cnt) {
    unsigned wd[16]; unsigned cl = 0u;
#pragma unroll
    for (int i = 0; i < 16; ++i) { wd[i] = h[17 * lane + i]; cl += (wd[i] & 0xffffu) + (wd[i] >> 16); }
    unsigned incl = cl;
#pragma unroll
    for (int off = 1; off < 64; off <<= 1) { const unsigned t = __shfl_down(incl, off); if (lane + off < 64) incl += t; }
    unsigned cum = incl - cl; const bool mine = (cum < krem) && (krem <= incl);
    int dg = -1; unsigned ab = 0u, cn = 0u;
#pragma unroll
    for (int i = 15; i >= 0; --i) {
        const unsigned hi = wd[i] >> 16, lo = wd[i] & 0xffffu;
        if (dg < 0 && cum + hi >= krem) { dg = 32 * lane + 2 * i + 1; ab = cum; cn = hi; } cum += hi;
        if (dg < 0 && cum + lo >= krem) { dg = 32 * lane + 2 * i; ab = cum; cn = lo; } cum += lo;
    }
    const unsigned long long bal = __ballot(mine); const int srcl = bal ? (__ffsll((long long)bal) - 1) : 0;
    digit = __shfl(dg, srcl); above = __shfl(ab, srcl); cnt = __shfl(cn, srcl);
}
__device__ __forceinline__ void idx_phase(const Params& P, LAS unsigned char* lds, int G, int c) {
    const int tid = threadIdx.x, w = rfl(tid >> 6), lane = tid & 63, r = lane & 31, hh = lane >> 5;
    const bf16_t* QIB = (const bf16_t*)(P.ws + WS_QIB); const float* WI = (const float*)(P.ws + WS_WI);
    float* scratch = P.out + (size_t)c * (32 * 8192) + (size_t)(4 * w) * 8192;
    LAS unsigned* hist = (LAS unsigned*)(lds + w * (4 * HQW * 4));
    for (int it = 0; it * G < NIDX_UNITS; ++it) {
        const int L = snake(it, G, c); if (L >= NIDX_UNITS) continue;
        int row0, n, nend, mpitch; const bf16_t* ki; unsigned* mk;
        const bool is_p = L < 760 || L >= 776; const int Lp = L < 760 ? L : L - 16;
        if (is_p) { const int hc = 255 - (Lp >> 2), b = Lp & 3, t0 = 32 * hc; row0 = b * SEQ + t0; n = 64 * ((hc >> 1) + 1); nend = 256 * ((t0 >> 8) + 1); mpitch = 256;
            ki = (const bf16_t*)(P.ws + WS_KIP) + (size_t)b * SEQ * 64; mk = (unsigned*)(P.ws + WS_MASKP) + (size_t)row0 * 256; }
        else { const int s = L - 760, bs = s >> 1, t0 = 32 * (s & 1); row0 = TP + bs * 64 + t0; n = SK; nend = SK; mpitch = 66;
            ki = (const bf16_t*)(P.ws + WS_KIS) + (size_t)bs * SK * 64; mk = (unsigned*)(P.ws + WS_MASKS) + (size_t)(bs * 64 + t0) * 66; }
        mk += (size_t)(4 * w) * mpitch;
        bf16x8 af[2][4]; f32x4 wv[2][4];
#pragma unroll
        for (int p = 0; p < 2; ++p) { const int t = 4 * w + 2 * p + ((r >> 2) & 1), head = (r & 3) + 4 * (r >> 3);
            const bf16_t* qrow = QIB + (size_t)(row0 + t) * 1024 + head * 64 + 8 * hh;
#pragma unroll
            for (int ks = 0; ks < 4; ++ks) af[p][ks] = *(const bf16x8*)(qrow + 16 * ks);
            const float* wrow = WI + (size_t)(row0 + 4 * w + 2 * p + hh) * 16;
#pragma unroll
            for (int q = 0; q < 4; ++q) wv[p][q] = *(const f32x4*)(wrow + 4 * q); }
        const bool all = n <= 256;
        for (int rep_s = 0; rep_s < IDX_REP_SCORE; ++rep_s) {
        for (int i = lane; i < 4 * HQW; i += 64) hist[i] = 0u;
        const bf16_t* kp = ki + (size_t)lane * 8;
        bf16x8 b0[4], b1[4], c0[4], c1[4];
        const int nsub = n >> 5, nsub4 = (nsub + 3) & ~3, lim = nsub4 - 1;
#define IDX_LOAD(bb_, sub_) do { _Pragma("unroll") for (int ks = 0; ks < 4; ++ks) bb_[ks] = *(const bf16x8*)(kp + (size_t)(sub_) * 2048 + 512 * ks); } while (0)
        IDX_LOAD(b0, 0); IDX_LOAD(b1, 1);
#define IDX_TAIL(sub_, p_, acc_) do { float s0_ = 0.f, s1_ = 0.f; _Pragma("unroll") for (int i = 0; i < 16; i += 2) { s0_ += wv[p_][i >> 2][i & 3] * __builtin_amdgcn_fmed3f(acc_[i], 0.f, 3.0e38f); s1_ += wv[p_][(i + 1) >> 2][(i + 1) & 3] * __builtin_amdgcn_fmed3f(acc_[i + 1], 0.f, 3.0e38f); } \
            const float sc_ = (s0_ + s1_) + 0.0f;     \
            scratch[(size_t)(2 * (p_) + hh) * 8192 + 32 * (sub_) + r] = sc_; \
            if (!all && (sub_) < nsub) { const unsigned bn_ = fkey(sc_) >> 21; __hip_atomic_fetch_add(hist + (2 * (p_) + hh) * HQW + (bn_ >> 1) + (bn_ >> 5), 1u << (16 * (bn_ & 1)), __ATOMIC_RELAXED, __HIP_MEMORY_SCOPE_WORKGROUP); } } while (0)
#define IDX_MMA(acc_, p_, bb_) do { _Pragma("unroll") for (int i = 0; i < 16; ++i) acc_[i] = 0.f; __builtin_amdgcn_s_setprio(1); _Pragma("unroll") for (int ks = 0; ks < 4; ++ks) acc_ = __builtin_amdgcn_mfma_f32_32x32x16_bf16(af[p_][ks], bb_[ks], acc_, 0, 0, 0); __builtin_amdgcn_s_setprio(0); } while (0)
        for (int sub = 0; sub < nsub4; sub += 4) {
            f32x16 accA;
            IDX_MMA(accA, 0, b0); asm volatile("" : "+v"(accA) : : "memory"); IDX_LOAD(c0, min(sub + 2, lim)); IDX_LOAD(c1, min(sub + 3, lim)); asm volatile("" : "+v"(accA) : : "memory");
            IDX_TAIL(sub, 0, accA);
            IDX_MMA(accA, 1, b0); IDX_TAIL(sub, 1, accA);
            IDX_MMA(accA, 0, b1); IDX_TAIL(sub + 1, 0, accA);
            IDX_MMA(accA, 1, b1); IDX_TAIL(sub + 1, 1, accA);
            IDX_MMA(accA, 0, c0);
            asm volatile("" : "+v"(accA) : : "memory"); IDX_LOAD(b0, min(sub + 4, lim)); IDX_LOAD(b1, min(sub + 5, lim)); asm volatile("" : "+v"(accA) : : "memory");
            IDX_TAIL(sub + 2, 0, accA);
            IDX_MMA(accA, 1, c0); IDX_TAIL(sub + 2, 1, accA);
            IDX_MMA(accA, 0, c1); IDX_TAIL(sub + 3, 0, accA);
            IDX_MMA(accA, 1, c1); IDX_TAIL(sub + 3, 1, accA);
        }
#undef IDX_MMA
#undef IDX_TAIL
#undef IDX_LOAD
        }
        asm volatile("s_waitcnt vmcnt(0) lgkmcnt(0)" ::: "memory");
#define SC_LOAD(vv_, jb_) do { _Pragma("unroll") for (int q = 0; q < 4; ++q) _Pragma("unroll") for (int k = 0; k < 2; ++k) { const int idx_ = (jb_) + 256 * k + 4 * lane; vv_[q][k] = *(const f32x4*)(scratch + (size_t)q * 8192 + (idx_ < n ? idx_ : 0)); } } while (0)
#define KEYINV(u_) (((u_) & 0x80000000u) ? ((u_) ^ 0x80000000u) : ~(u_))
        unsigned T[4] = {0u, 0u, 0u, 0u}; unsigned pm[4]; int kr[4]; bool dn[4]; unsigned cn1[4];
        bool fast = false;
        if (!all) {
#pragma unroll
            for (int q = 0; q < 4; ++q) { int dg; unsigned ab, cn; hscan(hist + q * HQW, 256u, lane, dg, ab, cn); T[q] = (unsigned)dg << 21; pm[q] = 0xFFE00000u; kr[q] = 256 - (int)ab; dn[q] = ((int)cn == kr[q]); cn1[q] = cn; }
            fast = !IDX_FORCE_SLOW && cn1[0] <= LCAP && cn1[1] <= LCAP && cn1[2] <= LCAP && cn1[3] <= LCAP;
        }
        if (fast) {
            LAS unsigned* lst = hist; LAS unsigned* h2 = hist + 4 * LCAP * 2;
            float loF[4], hiF[4]; unsigned base[4] = {0u, 0u, 0u, 0u};
#pragma unroll
            for (int q = 0; q < 4; ++q) { const unsigned hk = T[q] + (1u << 21); loF[q] = __uint_as_float(KEYINV(T[q])); hiF[q] = hk == 0u ? __builtin_inff() : __uint_as_float(KEYINV(hk)); if (dn[q]) hiF[q] = loF[q]; }
#define CB_PROC(vv_, jb_) do { _Pragma("unroll") for (int q = 0; q < 4; ++q) _Pragma("unroll") for (int k = 0; k < 2; ++k) { const int kb_ = (jb_) + 256 * k, idx_ = kb_ + 4 * lane; unsigned nib = 0u; const bool ok_ = idx_ < n; \
                    _Pragma("unroll") for (int e = 0; e < 4; ++e) { const float x_ = vv_[q][k][e]; const bool s_ = ok_ && x_ >= hiF[q]; const bool i_ = ok_ && !s_ && x_ >= loF[q]; nib |= (s_ ? 1u : 0u) << e; \
                        const unsigned long long bal_ = __ballot(i_); if (bal_) { const unsigned pos_ = base[q] + __builtin_amdgcn_mbcnt_hi((unsigned)(bal_ >> 32), __builtin_amdgcn_mbcnt_lo((unsigned)bal_, 0u)); \
                            if (i_) { lst[(q * LCAP + pos_) * 2] = __float_as_uint(x_); lst[(q * LCAP + pos_) * 2 + 1] = (unsigned)(idx_ + e); } base[q] += (unsigned)__popcll(bal_); } } \
                    unsigned wd = nib << (4 * (lane & 7)); wd |= __shfl_xor(wd, 1); wd |= __shfl_xor(wd, 2); wd |= __shfl_xor(wd, 4); \
                    const int widx = (kb_ >> 5) + (lane >> 3); if ((lane & 7) == 0 && widx < mpitch && kb_ < nend) mk[(size_t)q * mpitch + widx] = wd; } } while (0)
            { const int nbm = ((nend + 511) >> 9) + 1 & ~1;
              f32x4 va[4][2], vb[4][2];
              SC_LOAD(va, 0);
#if IDX_SELFCHECK
              for (int bt = 0; bt < nbm; ++bt) { SC_LOAD(vb, bt * 512); CB_PROC(vb, bt * 512); } (void)va;
#else
              for (int bt = 0; bt < nbm; bt += 2) { SC_LOAD(vb, (bt + 1) * 512); CB_PROC(va, bt * 512); SC_LOAD(va, (bt + 2) * 512); CB_PROC(vb, (bt + 1) * 512); }
#endif
            }
#undef CB_PROC
            asm volatile("s_waitcnt vmcnt(0) lgkmcnt(0)" ::: "memory");
#pragma unroll
            for (int q = 0; q < 4; ++q) if (!dn[q]) {
                const int m = (int)base[q]; unsigned Tq = T[q], pmq = pm[q]; int krq = kr[q];
                for (int pass = 1; pass < 3; ++pass) {
                    const int shift = pass == 1 ? 10 : 0; const unsigned dm = pass == 1 ? 2047u : 1023u;
                    for (int i = lane; i < HQW; i += 64) h2[i] = 0u;
                    for (int i = lane; i < m; i += 64) { const unsigned u = fkey(__uint_as_float(lst[(q * LCAP + i) * 2])); if ((u & pmq) == Tq) { const unsigned bn = (u >> shift) & dm; __hip_atomic_fetch_add(h2 + (bn >> 1) + (bn >> 5), 1u << (16 * (bn & 1)), __ATOMIC_RELAXED, __HIP_MEMORY_SCOPE_WORKGROUP); } }
                    int dg; unsigned ab, cn; hscan(h2, (unsigned)krq, lane, dg, ab, cn); Tq |= (unsigned)dg << shift; pmq |= dm << shift; krq -= (int)ab;
                    if ((int)cn == krq) break;
                }
                for (int i = lane; i < m; i += 64) { const unsigned u = fkey(__uint_as_float(lst[(q * LCAP + i) * 2])); if (u >= Tq) { const unsigned ix = lst[(q * LCAP + i) * 2 + 1]; __hip_atomic_fetch_or(mk + (size_t)q * mpitch + (ix >> 5), 1u << (ix & 31u), __ATOMIC_RELAXED, __HIP_MEMORY_SCOPE_AGENT); } }
            }
        } else {
            if (!all) {
                for (int pass = 1; pass < 3; ++pass) {
                    if (dn[0] && dn[1] && dn[2] && dn[3]) break;
                    const int shift = pass == 1 ? 10 : 0; const unsigned dm = pass == 1 ? 2047u : 1023u;
                    for (int i = lane; i < 4 * HQW; i += 64) hist[i] = 0u;
#define P2_PROC(vv_, jb_) do { _Pragma("unroll") for (int q = 0; q < 4; ++q) _Pragma("unroll") for (int k = 0; k < 2; ++k) { const int idx_ = (jb_) + 256 * k + 4 * lane; \
                    if (!dn[q] && idx_ < n) { _Pragma("unroll") for (int e = 0; e < 4; ++e) { const unsigned u = fkey(vv_[q][k][e]); \
                        if ((u & pm[q]) == T[q]) { const unsigned bn = (u >> shift) & dm; __hip_atomic_fetch_add(hist + q * HQW + (bn >> 1) + (bn >> 5), 1u << (16 * (bn & 1)), __ATOMIC_RELAXED, __HIP_MEMORY_SCOPE_WORKGROUP); } } } } } while (0)
                    { const int nb2 = ((n + 511) >> 9) + 1 & ~1;
                      f32x4 va[4][2], vb[4][2];
                      SC_LOAD(va, 0);
                      for (int bt = 0; bt < nb2; bt += 2) { SC_LOAD(vb, (bt + 1) * 512); P2_PROC(va, bt * 512); SC_LOAD(va, (bt + 2) * 512); P2_PROC(vb, (bt + 1) * 512); } }
#undef P2_PROC
#pragma unroll
                    for (int q = 0; q < 4; ++q) if (!dn[q]) { int dg; unsigned ab, cn; hscan(hist + q * HQW, (unsigned)kr[q], lane, dg, ab, cn); T[q] |= (unsigned)dg << shift; pm[q] |= dm << shift; kr[q] -= (int)ab; dn[q] = ((int)cn == kr[q]); }
                }
            }
            float Tf[4];
#pragma unroll
            for (int q = 0; q < 4; ++q) Tf[q] = all ? -__builtin_inff() : __uint_as_float(KEYINV(T[q]));
#define MK_PROC(vv_, jb_) do { _Pragma("unroll") for (int q = 0; q < 4; ++q) _Pragma("unroll") for (int k = 0; k < 2; ++k) { const int kb_ = (jb_) + 256 * k, idx_ = kb_ + 4 * lane; unsigned nib = 0u; \
                    _Pragma("unroll") for (int e = 0; e < 4; ++e) nib |= (vv_[q][k][e] >= Tf[q] ? 1u : 0u) << e; \
                    unsigned wd = (idx_ < n ? nib : 0u) << (4 * (lane & 7)); wd |= __shfl_xor(wd, 1); wd |= __shfl_xor(wd, 2); wd |= __shfl_xor(wd, 4); \
                    const int widx = (kb_ >> 5) + (lane >> 3); if ((lane & 7) == 0 && widx < mpitch && kb_ < nend) mk[(size_t)q * mpitch + widx] = wd; } } while (0)
            for (int rep_m = 0; rep_m < IDX_REP_MASK; ++rep_m) {
                const int nbm = ((nend + 511) >> 9) + 1 & ~1;
                f32x4 va[4][2], vb[4][2];
                SC_LOAD(va, 0);
                for (int bt = 0; bt < nbm; bt += 2) { SC_LOAD(vb, (bt + 1) * 512); MK_PROC(va, bt * 512); SC_LOAD(va, (bt + 2) * 512); MK_PROC(vb, (bt + 1) * 512); }
            }
#undef MK_PROC
        }
#undef SC_LOAD
#undef KEYINV
#if IDX_SELFCHECK
        asm volatile("s_waitcnt vmcnt(0) lgkmcnt(0)" ::: "memory");
#pragma unroll 1
        for (int q = 0; q < 4; ++q) {
            int cnt = 0; float smin = __builtin_inff(), umax = -__builtin_inff();
            for (int j = lane; j < nend; j += 64) {
                const unsigned wdv = __hip_atomic_load(mk + (size_t)q * mpitch + (j >> 5), __ATOMIC_RELAXED, __HIP_MEMORY_SCOPE_AGENT); const bool sel = (wdv >> (j & 31)) & 1u;
                if (j < n) { const float x = __hip_atomic_load(scratch + (size_t)q * 8192 + j, __ATOMIC_RELAXED, __HIP_MEMORY_SCOPE_AGENT); if (sel) { ++cnt; smin = fminf(smin, x); } else umax = fmaxf(umax, x); }
                else if (sel) ++cnt;
            }
#pragma unroll
            for (int o = 1; o < 64; o <<= 1) { cnt += __shfl_xor(cnt, o); smin = fminf(smin, __shfl_xor(smin, o)); umax = fmaxf(umax, __shfl_xor(umax, o)); }
            const int want = n < 256 ? n : 256;
            if (lane == 0 && (cnt != want || !(smin >= umax))) __hip_atomic_fetch_add((unsigned*)P.ws + 4000, 1u, __ATOMIC_RELAXED, __HIP_MEMORY_SCOPE_AGENT);
        }
#endif
    }
}

constexpr int NATT_UNITS = 1024 + 64;
__device__ __forceinline__ void attn_phase(const Params& P, LAS unsigned char* lds, int G, int c) {
    const int tid = threadIdx.x, w = rfl(tid >> 6), lane = tid & 63, l15 = lane & 15, g = lane >> 4;
    const bf16_t* QB = (const bf16_t*)(P.ws + WS_QB); bf16_t* MIX = (bf16_t*)(P.ws + WS_MIX);
    constexpr unsigned KOFF = 0u, VOFF = 65536u;
    const int srow = (w * 64 + lane) >> 4, spc = lane & 15;
    const int kch = spc ^ (srow & 15), vch = spc ^ (2 * (srow & 7));
    for (int it = 0; it * G < NATT_UNITS; ++it) {
        const int L = snake(it, G, c); if (L >= NATT_UNITS) continue;
        int row0, nq, ntiles, mpitch, h; const bf16_t *Kb, *Vb; const unsigned* mk;
        const bool is_p = L < 768 || L >= 832; const int Lp = L < 768 ? L : L - 64;
        if (is_p) { const int qb = 31 - (Lp >> 5), bh = Lp & 31, b = bh >> 3; h = bh & 7; row0 = b * SEQ + 256 * qb; nq = 256; ntiles = 4 * (qb + 1); mpitch = 256;
            Kb = (const bf16_t*)(P.ws + WS_KP) + (size_t)b * SEQ * 1024; Vb = (const bf16_t*)(P.ws + WS_VP) + (size_t)b * SEQ * 1024; mk = (const unsigned*)(P.ws + WS_MASKP) + (size_t)row0 * 256; }
        else { const int s = L - 768, bs = s >> 3; h = s & 7; row0 = TP + bs * 64; nq = 64; ntiles = SK / 64; mpitch = 66;
            Kb = (const bf16_t*)(P.ws + WS_KS) + (size_t)bs * SK * 1024; Vb = (const bf16_t*)(P.ws + WS_VS) + (size_t)bs * SK * 1024; mk = (const unsigned*)(P.ws + WS_MASKS) + (size_t)(bs * 64) * 66; }
        const bool active = 32 * w < nq;
        bf16x8 qf[2][4]; f32x4 O[2][9]; float mrun[2]; const unsigned* mrow[2];
        const bf16x8 ones = (bf16x8){0x3F80, 0x3F80, 0x3F80, 0x3F80, 0x3F80, 0x3F80, 0x3F80, 0x3F80};
#pragma unroll
        for (int qs = 0; qs < 2; ++qs) { mrun[qs] = -1e20f; const int ql = active ? 32 * w + 16 * qs + l15 : 0; mrow[qs] = mk + (size_t)ql * mpitch;
#pragma unroll
            for (int ks = 0; ks < 4; ++ks) qf[qs][ks] = *(const bf16x8*)(QB + (size_t)(row0 + ql) * 1024 + h * 128 + 32 * ks + 8 * g);
#pragma unroll
            for (int cc = 0; cc < 9; ++cc) O[qs][cc] = (f32x4){0.f, 0.f, 0.f, 0.f}; }
        const bf16_t* kg = Kb + (size_t)srow * 1024 + h * 128 + kch * 8; const bf16_t* vg = Vb + (size_t)srow * 1024 + h * 128 + vch * 8;
#define ATT_STAGE(kt_, buf_) do { const size_t go_ = (size_t)(64 * (kt_)) * 1024; LAS unsigned char* kd_ = lds + KOFF + (buf_) * 32768u + (unsigned)((kt_) & 1) * 16384u + (unsigned)w * 1024u; LAS unsigned char* vd_ = lds + VOFF + (buf_) * 32768u + (unsigned)((kt_) & 1) * 16384u + (unsigned)w * 1024u; \
            __builtin_amdgcn_global_load_lds((const unsigned*)(kg + go_), (LAS unsigned*)kd_, 16, 0, 0); __builtin_amdgcn_global_load_lds((const unsigned*)(kg + go_ + 32 * 1024), (LAS unsigned*)(kd_ + 8192), 16, 0, 0); \
            __builtin_amdgcn_global_load_lds((const unsigned*)(vg + go_), (LAS unsigned*)vd_, 16, 0, 0); __builtin_amdgcn_global_load_lds((const unsigned*)(vg + go_ + 32 * 1024), (LAS unsigned*)(vd_ + 8192), 16, 0, 0); } while (0)
        ATT_STAGE(0, 0u); if (ntiles > 1) ATT_STAGE(1, 0u);
        asm volatile("s_waitcnt vmcnt(0)" ::: "memory"); __syncthreads();
        for (int kt = 0; kt < ntiles; ++kt) {
            const unsigned sbuf = (unsigned)((kt >> 1) & 1);
            const unsigned kb = KOFF + sbuf * 32768u + (unsigned)(kt & 1) * 16384u, vb = VOFF + sbuf * 32768u + (unsigned)(kt & 1) * 16384u;
            if ((kt & 1) == 0) { if (kt + 2 < ntiles) ATT_STAGE(kt + 2, sbuf ^ 1u); if (kt + 3 < ntiles) ATT_STAGE(kt + 3, sbuf ^ 1u); }
            if (active) {
                f32x4 S[2][4];
#pragma unroll
                for (int qs = 0; qs < 2; ++qs)
#pragma unroll
                    for (int sub = 0; sub < 4; ++sub) S[qs][sub] = (f32x4){0.f, 0.f, 0.f, 0.f};
                __builtin_amdgcn_s_setprio(1);
#pragma unroll
                for (int sub = 0; sub < 4; ++sub)
#pragma unroll
                    for (int ks = 0; ks < 4; ++ks) { const bf16x8 kf = *(const LAS bf16x8*)(lds + kb + (16 * sub + l15) * 256 + (((4 * ks + g) ^ l15) * 16));
#pragma unroll
                        for (int qs = 0; qs < 2; ++qs) S[qs][sub] = __builtin_amdgcn_mfma_f32_16x16x32_bf16(kf, qf[qs][ks], S[qs][sub], 0, 0, 0); }
                __builtin_amdgcn_s_setprio(0);
                bf16x8 pf[2][2];
#pragma unroll
                for (int qs = 0; qs < 2; ++qs) {
                    const u32x2 mw = *(const u32x2*)(mrow[qs] + 2 * kt);
                    const unsigned m0 = mw.x >> (4 * g), m1 = mw.y >> (4 * g);
                    float sv[4][4]; float mx = -1e30f;
#pragma unroll
                    for (int sub = 0; sub < 4; ++sub)
#pragma unroll
                        for (int i = 0; i < 4; ++i) { const unsigned word = (sub >> 1) ? m1 : m0; const unsigned t = (unsigned)__builtin_amdgcn_sbfe((int)word, 16 * (sub & 1) + i, 1);
                            sv[sub][i] = __uint_as_float((__float_as_uint(S[qs][sub][i]) & t) | (0xF149F2CAu & ~t));     mx = fmaxf(mx, sv[sub][i]); }
                    mx = fmaxf(mx, __shfl_xor(mx, 16)); mx = fmaxf(mx, __shfl_xor(mx, 32));
                    const float mnew = fmaxf(mrun[qs], mx);
                    if (__any(mnew != mrun[qs])) {
                        const float alpha = __builtin_amdgcn_exp2f(mrun[qs] - mnew);
#pragma unroll
                        for (int cc = 0; cc < 9; ++cc) O[qs][cc] = O[qs][cc] * alpha;
                    }
                    mrun[qs] = mnew;
                    f32x4 pp[4];
#pragma unroll
                    for (int sub = 0; sub < 4; ++sub)
#pragma unroll
                        for (int i = 0; i < 4; ++i) pp[sub][i] = __builtin_amdgcn_exp2f(sv[sub][i] - mnew);
#pragma unroll
                    for (int k2 = 0; k2 < 2; ++k2) { const u32x4 pw = pack8(pp[2 * k2], pp[2 * k2 + 1]); pf[qs][k2] = __builtin_bit_cast(bf16x8, pw); }
                }
                const int vxh = 4 * (g & 1) + (l15 >> 2);
                __builtin_amdgcn_s_setprio(1);
                const LAS unsigned char* vp = lds + vb + (4 * g + (l15 >> 2)) * 256 + ((lane >> 1) & 1) * 16 + (lane & 1) * 8;
#pragma unroll
                for (int cc = 0; cc < 8; ++cc)
#pragma unroll
                    for (int k2 = 0; k2 < 2; ++k2) {
                        const s16x4 va = __builtin_amdgcn_ds_read_tr16_b64_v4i16((LAS s16x4*)(vp + (32 * k2) * 256 + ((cc ^ vxh) * 32)));
                        const s16x4 vbv = __builtin_amdgcn_ds_read_tr16_b64_v4i16((LAS s16x4*)(vp + (32 * k2 + 16) * 256 + ((cc ^ vxh) * 32)));
                        const bf16x8 vf = (bf16x8){va[0], va[1], va[2], va[3], vbv[0], vbv[1], vbv[2], vbv[3]};
#pragma unroll
                        for (int qs = 0; qs < 2; ++qs) O[qs][cc] = __builtin_amdgcn_mfma_f32_16x16x32_bf16(vf, pf[qs][k2], O[qs][cc], 0, 0, 0);
                    }
#pragma unroll
                for (int k2 = 0; k2 < 2; ++k2)
#pragma unroll
                    for (int qs = 0; qs < 2; ++qs) O[qs][8] = __builtin_amdgcn_mfma_f32_16x16x32_bf16(ones, pf[qs][k2], O[qs][8], 0, 0, 0);
                __builtin_amdgcn_s_setprio(0);
            }
            if ((kt & 1) || kt + 1 == ntiles) { asm volatile("s_waitcnt vmcnt(0)" ::: "memory"); __syncthreads(); }
        }
#undef ATT_STAGE
        if (active) {
#pragma unroll
            for (int qs = 0; qs < 2; ++qs) { const float inv = 1.0f / O[qs][8][0];
                bf16_t* orow = MIX + (size_t)(row0 + 32 * w + 16 * qs + l15) * 2048 + h * 128 + 4 * g;
#pragma unroll
                for (int cc = 0; cc < 8; ++cc) *(u32x2*)(orow + 16 * cc) = pack4(O[qs][cc] * inv); }
        }
    }
}


#define XB_TMO      128
#define XB_XCNT(j)  (256  + 64 * (j))
#define XB_XSUB(j)  (1280 + 64 * (j))
#define XB_XGEN(j)  (2304 + 64 * (j))
#define XB_TOP      3328
#define XB_TOPGEN   3392
#define XCD_BAR_WORDS 3456
#define XB_SPIN_CAP (1u << 20)
__device__ __forceinline__ unsigned xb_ld(unsigned* p)              { return __hip_atomic_load(p, __ATOMIC_RELAXED, __HIP_MEMORY_SCOPE_AGENT); }
__device__ __forceinline__ unsigned xb_add(unsigned* p, unsigned v) { return __hip_atomic_fetch_add(p, v, __ATOMIC_RELAXED, __HIP_MEMORY_SCOPE_AGENT); }
__device__ __forceinline__ unsigned xb_xcc_id() { return (unsigned)__builtin_amdgcn_s_getreg((3 << 11) | 20) & 0xFu; }
#define XB_SPIN(cond, bar) do { unsigned _sp = 0; while (cond) { __builtin_amdgcn_s_sleep(1); \
    if ((++_sp & 255u) == 0u) { if (xb_ld(&(bar)[XB_TMO])) break; if (_sp > XB_SPIN_CAP) { atomicAdd(&(bar)[XB_TMO], 1u); break; } } } } while (0)
struct XcdBarrier { unsigned* bar; unsigned x; volatile LAS unsigned* st; };
__device__ __forceinline__ XcdBarrier xcd_barrier_post(unsigned* bar, volatile LAS unsigned* st) {
    XcdBarrier b; b.bar = bar; b.x = xb_xcc_id(); b.st = st;
    if (threadIdx.x == 0) (void)xb_add(&bar[XB_XCNT(b.x)], 1u);
    return b;
}
__device__ __forceinline__ void xcd_barrier_complete(unsigned* bar, unsigned x, unsigned& nloc, unsigned& nx) {
    const unsigned G = gridDim.x * gridDim.y * gridDim.z;
    unsigned sum, cnt, mine, sp = 0u;
    for (;;) {
        sum = 0u; cnt = 0u; mine = 0u;
#pragma unroll
        for (unsigned j = 0; j < 16; ++j) { const unsigned c = xb_ld(&bar[XB_XCNT(j)]); sum += c; cnt += (c > 0u) ? 1u : 0u; mine = (j == x) ? c : mine; }
        if (sum == G) break;
        __builtin_amdgcn_s_sleep(1);
        if ((++sp & 255u) == 0u) { if (xb_ld(&bar[XB_TMO])) break; if (sp > XB_SPIN_CAP) { atomicAdd(&bar[XB_TMO], 1u); break; } }
    }
    nloc = mine > 0u ? mine : 1u; nx = cnt > 0u ? cnt : 1u;
}
__device__ __forceinline__ void xcd_barrier(const XcdBarrier& b) {
    asm volatile("s_waitcnt vmcnt(0)" ::: "memory");
    __syncthreads();
    if (threadIdx.x == 0) {
        unsigned* bar = b.bar;
        __builtin_amdgcn_s_waitcnt(0);
        unsigned nloc = b.st[0], nx = b.st[1];
        if (nloc == 0u) { xcd_barrier_complete(bar, b.x, nloc, nx); b.st[0] = nloc; b.st[1] = nx; }
        const unsigned old = xb_add(&bar[XB_XSUB(b.x)], 1u);
        const unsigned gen = old / nloc;
        if (old + 1u == (gen + 1u) * nloc) {
            __builtin_amdgcn_fence(__ATOMIC_RELEASE, "agent");
            asm volatile("s_waitcnt vmcnt(0)" ::: "memory");
            const unsigned og = xb_add(&bar[XB_TOP], 1u);
            const unsigned tg = og / nx;
            if (og + 1u == (tg + 1u) * nx) xb_add(&bar[XB_TOPGEN], 1u);
            else XB_SPIN(xb_ld(&bar[XB_TOPGEN]) == tg, bar);
            __builtin_amdgcn_fence(__ATOMIC_ACQUIRE, "agent");
            xb_add(&bar[XB_XGEN(b.x)], 1u);
            asm volatile("s_waitcnt vmcnt(0)" ::: "memory");
        } else {
            XB_SPIN(xb_ld(&bar[XB_XGEN(b.x)]) == gen, bar);
            __builtin_amdgcn_fence(__ATOMIC_ACQUIRE, "agent");
            asm volatile("s_waitcnt vmcnt(0)" ::: "memory");
        }
    }
    __syncthreads();
}

__global__ void __launch_bounds__(NTHREADS) fwd_kernel(Params P) {
    extern __shared__ __attribute__((aligned(16))) unsigned char lds_raw[];
    LAS unsigned char* lds = (LAS unsigned char*)lds_raw;
    const int G = gridDim.x, c = blockIdx.x;
    const int lo = P.lo, hi = P.hi;
#define IN(k) (lo <= (k) && (k) < hi)
#define REP(k) for (int rep_ = 0; rep_ < ((k) == DUP_PHASE ? 2 : 1); ++rep_)
#define SEAM(k) do { if (IN(k) && IN((k) + 1)) { if ((k) == 0) { cg::this_grid().sync(); bar = xcd_barrier_post((unsigned*)P.ws, bst); } else xcd_barrier(bar); } } while (0)
    volatile LAS unsigned* bst = (volatile LAS unsigned*)(lds + 139264);
    if (threadIdx.x < 2) bst[threadIdx.x] = 0u;
    if (c == 0 && N_LAUNCH == 1) for (int i = threadIdx.x; i < 4096; i += NTHREADS) ((unsigned*)P.ws)[i] = 0u;
    __syncthreads();
    XcdBarrier bar; bar.bar = (unsigned*)P.ws; bar.x = 0; bar.st = bst;
    bf16_t* H = (bf16_t*)(P.ws + WS_H); bf16_t* MIX = (bf16_t*)(P.ws + WS_MIX); const float* mods = (const float*)(P.ws + WS_MODS);
    if (IN(0)) REP(0) phase0(P, lds, G, c);
    SEAM(0);
    if (IN(1)) REP(1) norm_phase<0>(P, G, c);
    SEAM(1);
    if (IN(2)) REP(2) {
        pg8::Gemm g{H, (const bf16_t*)(P.ws + WS_WIN), MT, NINP, D, D, D, 0, 30, 0}; pg8::StaticOrder S; S.init(MT, NINP, G, c);
        EpiIn E{(bf16_t*)(P.ws + WS_QB), (bf16_t*)(P.ws + WS_QIB), (bf16_t*)(P.ws + WS_KP), (bf16_t*)(P.ws + WS_VP), (bf16_t*)(P.ws + WS_KS), (bf16_t*)(P.ws + WS_VS),
                (bf16_t*)(P.ws + WS_KIP), (bf16_t*)(P.ws + WS_KIS), (bf16_t*)(P.ws + WS_U), (float*)(P.ws + WS_WI), P.out};
        pg8::gemm_phase<EpiIn, false>(lds, g, S, E);
    }
    SEAM(2);
    if (IN(3)) { REP(3) idx_phase(P, lds, G, c); z_phase(P, G, c); }
    SEAM(3);
    if (IN(4)) {
        REP(4) attn_phase(P, lds, G, c);
        pg8::Gemm g{(const bf16_t*)(P.ws + WS_Z), (const bf16_t*)(P.ws + WS_WPOOL), MT, 1024, 256, 1024, 256, 512, 30, 0}; pg8::StaticOrder S; S.init(MT, 1024, G, c);
        EpiPool E{MIX, P.pscale};
        pg8::gemm_phase(lds, g, S, E);
    }
    SEAM(4);
    if (IN(5)) REP(5) {
        pg8::Gemm g{MIX, (const bf16_t*)(P.ws + WS_WOUT), TP, D, D, D, D, 0, 30, 0}; pg8::StaticOrder S; S.init(TP, D, G, c);
        EpiRes<0> E{P.xp, P.xs, mods, P.out};
        pg8::gemm_phase(lds, g, S, E);
        pg8::Gemm g2{MIX + (size_t)TP * D, (const bf16_t*)(P.ws + WS_WOUT), TS, D * 8, 256, D, D, 0, 3, 512}; pg8::StaticOrder S2; S2.init(TS, D * 8, G, c);
        EpiPart E2{(float*)(P.ws + WS_PART1)};
        pg8::gemm_phase(lds, g2, S2, E2);
    }
    SEAM(5);
    if (IN(6)) REP(6) norm_phase<1>(P, G, c);
    SEAM(6);
    if (IN(7)) REP(7) {
        pg8::Gemm g{H, (const bf16_t*)(P.ws + WS_WGU), MT, 2 * DFF, D, D, D, 0, 30, 0}; pg8::StaticOrder S; S.init(MT, 2 * DFF, G, c);
        EpiGU E{(bf16_t*)(P.ws + WS_ACT)};
        pg8::gemm_phase(lds, g, S, E);
    }
    SEAM(7);
    if (IN(8)) {
        pg8::Gemm g{(const bf16_t*)(P.ws + WS_ACT), (const bf16_t*)(P.ws + WS_WDN), TP, D, DFF, DFF, DFF, 0, 30, 0}; pg8::StaticOrder S; S.init(TP, D, G, c);
        EpiRes<1> E{P.xp, P.xs, mods, P.out};
        pg8::gemm_phase(lds, g, S, E);
        pg8::Gemm g2{(const bf16_t*)(P.ws + WS_ACT) + (size_t)TP * DFF, (const bf16_t*)(P.ws + WS_WDN), TS, D * 11, 512, DFF, DFF, 0, 3, 1024}; pg8::StaticOrder S2; S2.init(TS, D * 11, G, c);
        EpiPart E2{(float*)(P.ws + WS_PART2)};
        pg8::gemm_phase(lds, g2, S2, E2);
    }
    SEAM(8);
    if (IN(9)) norm_phase<2>(P, G, c);
#if IDX_SELFCHECK
    if (IN(9) && c == 0 && threadIdx.x == 0) { asm volatile("s_waitcnt vmcnt(0)" ::: "memory"); if (__hip_atomic_load((unsigned*)P.ws + 4000, __ATOMIC_RELAXED, __HIP_MEMORY_SCOPE_AGENT) != 0u) P.out[0] = __builtin_nanf(""); }
#endif
#undef IN
#undef SEAM
}

extern "C" void kernel_launch(void* const* d_in, const int* in_sizes, int n_in, void* d_out, int out_size, void* d_ws, size_t ws_size, hipStream_t stream) {
    static int grid = 0;
    if (grid == 0) {
        if (n_in != 20 || (size_t)out_size != O_END || ws_size < WS_END) { fprintf(stderr, "kernel_launch: unexpected shapes (n_in %d, out %d, ws %zu)\n", n_in, out_size, ws_size); grid = -1; return; }
        int dev = 0, cus = 0, per_cu = 0;
        hipGetDevice(&dev); hipDeviceGetAttribute(&cus, hipDeviceAttributeMultiprocessorCount, dev);
        if (hipFuncSetAttribute((const void*)fwd_kernel, hipFuncAttributeMaxDynamicSharedMemorySize, LDS_BYTES) != hipSuccess) { fprintf(stderr, "kernel_launch: hipFuncSetAttribute failed\n"); grid = -1; return; }
        if (hipOccupancyMaxActiveBlocksPerMultiprocessor(&per_cu, (const void*)fwd_kernel, NTHREADS, LDS_BYTES) != hipSuccess || per_cu < 1) { fprintf(stderr, "kernel_launch: occupancy query says %d blocks per CU\n", per_cu); per_cu = 1; }
        (void)hipGetLastError();
        grid = cus * per_cu; if (grid > 256) grid = 256;
    }
    if (grid < 0) return;
    Params p{};
    const float** pp = (const float**)&p;
    for (int i = 0; i < 20; ++i) pp[i] = (const float*)d_in[i];
    p.out = (float*)d_out; p.ws = (unsigned char*)d_ws;
    if (N_LAUNCH == 1) {
        p.lo = 0; p.hi = 10;
        void* args[] = {&p};
        hipError_t e = hipLaunchCooperativeKernel((const void*)fwd_kernel, dim3(grid), dim3(NTHREADS), args, LDS_BYTES, stream);
        if (e != hipSuccess) fprintf(stderr, "cooperative launch failed: %s (grid %d)\n", hipGetErrorString(e), grid);
    } else {
        for (int k = 0; k < 10; ++k) { p.lo = k; p.hi = k + 1; hipLaunchKernelGGL(fwd_kernel, dim3(grid), dim3(NTHREADS), LDS_BYTES, stream, p); }
    }
}
```

```cpp
#include <hip/hip_runtime.h>
#include <hip/hip_cooperative_groups.h>
#include <cstdio>
#include <cstdint>
namespace cg = cooperative_groups;

#ifndef N_LAUNCH
#define N_LAUNCH 1
#endif
#ifndef IDX_REP_SCORE
#define IDX_REP_SCORE 1
#endif
#ifndef IDX_REP_MASK
#define IDX_REP_MASK 1
#endif
#ifndef DUP_PHASE
#define DUP_PHASE -1
#endif

#define LAS __attribute__((address_space(3)))
typedef unsigned short bf16_t;
typedef short bf16x8 __attribute__((ext_vector_type(8)));
typedef short s16x4 __attribute__((ext_vector_type(4)));
typedef float f32x2 __attribute__((ext_vector_type(2)));
typedef float f32x4 __attribute__((ext_vector_type(4)));
typedef float f32x16 __attribute__((ext_vector_type(16)));
typedef unsigned u32x2 __attribute__((ext_vector_type(2)));
typedef unsigned u32x4 __attribute__((ext_vector_type(4)));

constexpr int D = 2048, NBP = 4, SEQ = 8192, TP = NBP * SEQ, NBS = 8, DSEQ = 64, TS = NBS * DSEQ, MT = TP + TS;
constexpr int PAST = 2048, SK = PAST + DSEQ, AW = 1024, HD = 128, IDIM = 64, DFF = 5632, NIN = 5200, NINP = 5376;
constexpr int MODW = 6 * D;
constexpr int NTHREADS = 512, NWAVES = 8;
constexpr size_t O_KP = (size_t)MT * D;
constexpr size_t O_VP = O_KP + (size_t)TP * AW;
constexpr size_t O_KIP = O_VP + (size_t)TP * AW;
constexpr size_t O_PP = O_KIP + (size_t)TP * IDIM;
constexpr size_t O_KS = O_PP + (size_t)NBP * 15 * 1024;
constexpr size_t O_VS = O_KS + (size_t)TS * AW;
constexpr size_t O_KIS = O_VS + (size_t)TS * AW;
constexpr size_t O_PS = O_KIS + (size_t)TS * IDIM;
constexpr size_t O_END = O_PS + (size_t)NBS * 15 * 1024;
constexpr size_t MiB = 1u << 20;
constexpr size_t WS_MODS = 1 * MiB, WS_WIN = 2 * MiB, WS_WOUT = 23 * MiB, WS_WGU = 31 * MiB, WS_WDN = 75 * MiB, WS_WPOOL = 97 * MiB;
constexpr size_t WS_KIP = 98 * MiB, WS_KIS = 102 * MiB, WS_WI = 105 * MiB, WS_MASKP = 108 * MiB, WS_MASKS = 140 * MiB;
constexpr size_t WS_QB = 141 * MiB, WS_QIB = 206 * MiB, WS_KP = 271 * MiB, WS_VP = 335 * MiB, WS_KS = 399 * MiB, WS_VS = 432 * MiB;
constexpr size_t WS_PART1 = 500 * MiB, WS_PART2 = 540 * MiB;
constexpr size_t WS_U = 465 * MiB, WS_Z = 595 * MiB, WS_H = 660 * MiB, WS_MIX = 790 * MiB, WS_ACT = 141 * MiB, WS_END = 920 * MiB;
static_assert(WS_ACT + (size_t)MT * DFF * 2 <= WS_PART1 && WS_PART1 + (size_t)8 * TS * D * 4 <= WS_PART2 && WS_PART2 + (size_t)11 * TS * D * 4 <= WS_Z, "ACT overlay / partials");
constexpr int LDS_BYTES = 139264 + 64;

struct Params {
    const float *xp, *xs, *cp, *cs, *ck, *cv, *cki, *sp, *wada, *bada, *g1, *win, *wpool, *pscale, *wout, *g2, *wgate, *wup, *wdown, *gf;
    float* out; unsigned char* ws; int lo, hi;
};

__device__ __forceinline__ int rfl(int v) { return __builtin_amdgcn_readfirstlane(v); }
__device__ __forceinline__ unsigned cvt_pk_bf16(float lo, float hi) { unsigned r; asm volatile("v_cvt_pk_bf16_f32 %0, %1, %2" : "=v"(r) : "v"(lo), "v"(hi)); return r; }
__device__ __forceinline__ u32x4 pack8(f32x4 a, f32x4 b) { u32x4 w; w.x = cvt_pk_bf16(a[0], a[1]); w.y = cvt_pk_bf16(a[2], a[3]); w.z = cvt_pk_bf16(b[0], b[1]); w.w = cvt_pk_bf16(b[2], b[3]); return w; }
__device__ __forceinline__ u32x2 pack4(f32x4 a) { u32x2 w; w.x = cvt_pk_bf16(a[0], a[1]); w.y = cvt_pk_bf16(a[2], a[3]); return w; }
__device__ __forceinline__ float wave_sum(float v) {
#pragma unroll
    for (int o = 1; o < 64; o <<= 1) v += __shfl_xor(v, o);
    return v;
}
__device__ __forceinline__ int snake(int it, int G, int c) { return it * G + ((it & 1) ? (G - 1 - c) : c); }
__device__ __forceinline__ int modrow(int r) { return r < TP ? (r >> 13) : 4 + ((r - TP) >> 6); }

namespace pg8 {
constexpr int BM = 256, BK = 64, HALF = 128, HTB = HALF * BK * 2, STAGE_BYTES = 8 * HTB, NXCD = 8, WGM = 8;
__host__ __device__ __forceinline__ int lds_byte(int r, int c) { const int st = (r >> 4) * 2 + (c >> 5), rr = r & 15, cc = c & 31, ob = rr * 64 + cc * 2; return st * 1024 + (ob ^ (((ob >> 9) & 1) << 5)); }
__host__ __device__ __forceinline__ void stage_rc(int b, int& R, int& C) { const int st = b / 1024, sb = b % 1024, swz = sb ^ (((sb >> 9) & 1) << 5); R = (st >> 1) * 16 + swz / 64; C = (st & 1) * 32 + (swz % 64) / 2; }
__host__ __device__ __forceinline__ int perm32(int rho) { const int n = rho >> 4, i = rho & 15; return 8 * (i >> 2) + 4 * n + (i & 3); }
struct Unit { int pm, pn; };
struct Gemm { const bf16_t* A; const bf16_t* Bt; int M, N, K, lda, ldb; size_t a_pn_step; int ks_shift; size_t ks_bytes; };
struct StaticOrder {
    int nM, nN, nwg, G, c;
    __host__ __device__ void init(int M, int N, int G_, int c_) { nM = M / BM; nN = N / BM; nwg = nM * nN; G = G_; c = c_; }
    __host__ __device__ bool next(int i, Unit& u) const {
        const long L = (long)i * G + c; if (L >= nwg) return false;
        int wgid = (int)L; { const int q = nwg / NXCD, r = nwg % NXCD, xcd = wgid % NXCD, off = wgid / NXCD; wgid = (xcd < r ? xcd * (q + 1) : r * (q + 1) + (xcd - r) * q) + off; }
        const int nig = WGM * nN, gid = wgid / nig, fm = gid * WGM, gsz = (nM - fm) < WGM ? (nM - fm) : WGM;
        u.pm = fm + ((wgid % nig) % gsz); u.pn = (wgid % nig) / gsz; return true;
    }
};
template <class Epi, bool ALIGN_EPI = true>
__device__ __forceinline__ void gemm_phase(LAS unsigned char* lds, const Gemm g, const StaticOrder& S, const Epi& E) {
    const int tid = threadIdx.x, wid = __builtin_amdgcn_readfirstlane(tid >> 6), lane = tid & 63, wr = wid >> 2, wc = wid & 3, fr = lane & 15, fq = lane >> 4;
    const int K = g.K, nt = K / BK;
    unsigned voffA[2], voffB[2];
#pragma unroll
    for (int i = 0; i < 2; ++i) { int R, C; stage_rc(tid * 16 + i * 8192, R, C); const int Rb = (R & ~31) + perm32(R & 31);
        voffA[i] = (unsigned)(R * g.lda + C) * 2u; voffB[i] = (unsigned)(Rb * g.ldb + C) * 2u; }
    const size_t kstep = (size_t)(BK * 2);
    const size_t hstepA = (size_t)HALF * g.lda * 2, hstepB = (size_t)HALF * g.ldb * 2;
    const size_t tstepA = 2 * hstepA, tstepB = 2 * hstepB;
    const unsigned ldsw = (unsigned)wid * 1024u;
    const int aoff = lds_byte(wr * 64 + fr, fq * 8), boff = lds_byte(wc * 32 + fr, fq * 8);
#define PG8_SA(b, h) (((b) * 2 + (h)) * HTB)
#define PG8_SB(b, h) ((4 + (b) * 2 + (h)) * HTB)
#define PG8_STAGE(bufoff, gbase, voff) do { _Pragma("unroll") for (int _i = 0; _i < 2; ++_i) \
        __builtin_amdgcn_global_load_lds((const unsigned*)((const char*)(gbase) + (voff)[_i]), (LAS unsigned*)(lds + (bufoff) + ldsw + _i * 8192), 16, 0, 0); } while (0)
#define PG8_LDA(dst, b, h) do { _Pragma("unroll") for (int m = 0; m < 4; ++m) _Pragma("unroll") for (int k = 0; k < 2; ++k) dst[m][k] = *(const LAS bf16x8*)(lds + PG8_SA(b, h) + aoff + m * 2048 + k * 1024); } while (0)
#define PG8_LDB(dst, b, h) do { _Pragma("unroll") for (int n = 0; n < 2; ++n) _Pragma("unroll") for (int k = 0; k < 2; ++k) dst[n][k] = *(const LAS bf16x8*)(lds + PG8_SB(b, h) + boff + n * 2048 + k * 1024); } while (0)
#define PG8_MMA(ai, bj, At, Bt) do { __builtin_amdgcn_s_setprio(1); _Pragma("unroll") for (int m = 0; m < 4; ++m) _Pragma("unroll") for (int n = 0; n < 2; ++n) _Pragma("unroll") for (int k = 0; k < 2; ++k) \
        acc[ai][bj][m][n] = __builtin_amdgcn_mfma_f32_16x16x32_bf16(Bt[n][k], At[m][k], acc[ai][bj][m][n], 0, 0, 0); __builtin_amdgcn_s_setprio(0); } while (0)
#define PG8_WAIT_V(n) asm volatile("s_waitcnt vmcnt(" #n ")" ::: "memory")
#define PG8_WAIT_L(n) asm volatile("s_waitcnt lgkmcnt(" #n ")" ::: "memory")
#define PG8_BAR __builtin_amdgcn_s_barrier()
#define PG8_SCHED __builtin_amdgcn_sched_barrier(0)
    Unit cur, nxt; int ui = 0;
    if (!S.next(0, cur)) return;
    f32x4 acc[2][2][4][2];
#pragma unroll
    for (int a = 0; a < 2; ++a)
#pragma unroll
        for (int b = 0; b < 2; ++b)
#pragma unroll
            for (int m = 0; m < 4; ++m)
#pragma unroll
                for (int n = 0; n < 2; ++n) acc[a][b][m][n] = (f32x4){0.f, 0.f, 0.f, 0.f};
    bf16x8 At[4][2], B0[2][2], B1[2][2];
    const int ksm = (1 << g.ks_shift) - 1;
    const char* cA = (const char*)g.A + (size_t)cur.pm * tstepA + (size_t)cur.pn * g.a_pn_step + (size_t)(cur.pn >> g.ks_shift) * g.ks_bytes; const char* cB = (const char*)g.Bt + (size_t)(cur.pn & ksm) * tstepB + (size_t)(cur.pn >> g.ks_shift) * g.ks_bytes;
    PG8_STAGE(PG8_SB(0, 0), cB, voffB); PG8_STAGE(PG8_SB(0, 1), cB + hstepB, voffB); PG8_STAGE(PG8_SA(0, 0), cA, voffA); PG8_STAGE(PG8_SA(0, 1), cA + hstepA, voffA);
    if (wr == 1) PG8_BAR;
    PG8_WAIT_V(2); PG8_BAR;
    PG8_STAGE(PG8_SB(1, 0), cB + kstep, voffB); PG8_STAGE(PG8_SA(1, 0), cA + kstep, voffA); PG8_STAGE(PG8_SB(1, 1), cB + hstepB + kstep, voffB);
    PG8_WAIT_V(6); PG8_BAR;
    for (;;) {
        const bool has_next = S.next(ui + 1, nxt);
        const char* nA = has_next ? (const char*)g.A + (size_t)nxt.pm * tstepA + (size_t)nxt.pn * g.a_pn_step + (size_t)(nxt.pn >> g.ks_shift) * g.ks_bytes : cA; const char* nB = has_next ? (const char*)g.Bt + (size_t)(nxt.pn & ksm) * tstepB + (size_t)(nxt.pn >> g.ks_shift) * g.ks_bytes : cB;
#pragma unroll 1
        for (int t = 0; t < nt; t += 2) {
            const bool last = (t == nt - 2);
            const char* a1 = cA + (size_t)(t + 1) * kstep;
            const char* a2 = last ? nA : cA + (size_t)(t + 2) * kstep; const char* b2 = last ? nB : cB + (size_t)(t + 2) * kstep;
            const char* a3 = a2 + kstep; const char* b3 = b2 + kstep;
            PG8_LDB(B0, 0, 0); PG8_LDB(B1, 0, 1); PG8_SCHED; PG8_LDA(At, 0, 0); PG8_STAGE(PG8_SA(1, 1), a1 + hstepA, voffA);
            PG8_WAIT_V(8); PG8_WAIT_L(0); PG8_BAR; PG8_MMA(0, 0, At, B0); PG8_MMA(0, 1, At, B1); PG8_BAR; PG8_SCHED;
            PG8_LDA(At, 0, 1); PG8_STAGE(PG8_SB(0, 0), b2, voffB); PG8_STAGE(PG8_SB(0, 1), b2 + hstepB, voffB); PG8_STAGE(PG8_SA(0, 0), a2, voffA);
            PG8_WAIT_V(8); PG8_WAIT_L(0); PG8_BAR; PG8_MMA(1, 0, At, B0); PG8_MMA(1, 1, At, B1); PG8_BAR; PG8_SCHED;
            PG8_LDB(B0, 1, 0); PG8_LDB(B1, 1, 1); PG8_SCHED; PG8_LDA(At, 1, 0); PG8_STAGE(PG8_SA(0, 1), a2 + hstepA, voffA);
            PG8_WAIT_V(8); PG8_WAIT_L(0); PG8_BAR; PG8_MMA(0, 0, At, B0); PG8_MMA(0, 1, At, B1); PG8_BAR; PG8_SCHED;
            PG8_LDA(At, 1, 1); PG8_STAGE(PG8_SB(1, 0), b3, voffB); PG8_STAGE(PG8_SB(1, 1), b3 + hstepB, voffB); PG8_STAGE(PG8_SA(1, 0), a3, voffA);
            PG8_WAIT_V(8); PG8_WAIT_L(0); PG8_BAR; PG8_MMA(1, 0, At, B0); PG8_MMA(1, 1, At, B1); PG8_BAR; PG8_SCHED;
        }
        if (ALIGN_EPI) { if (wr == 0) PG8_BAR; }
        E(acc, cur, wr, wc, fr, fq);
        if (!has_next) break;
#pragma unroll
        for (int a = 0; a < 2; ++a)
#pragma unroll
            for (int b = 0; b < 2; ++b)
#pragma unroll
                for (int m = 0; m < 4; ++m)
#pragma unroll
                    for (int n = 0; n < 2; ++n) acc[a][b][m][n] = (f32x4){0.f, 0.f, 0.f, 0.f};
        cur = nxt; cA = nA; cB = nB; ++ui;
        if (ALIGN_EPI) { if (wr == 1) PG8_BAR; }
    }
    PG8_WAIT_V(0);
    if (!ALIGN_EPI) { if (wr == 0) PG8_BAR; }
    PG8_BAR;
#undef PG8_SA
#undef PG8_SB
#undef PG8_STAGE
#undef PG8_LDA
#undef PG8_LDB
#undef PG8_MMA
#undef PG8_WAIT_V
#undef PG8_WAIT_L
#undef PG8_BAR
#undef PG8_SCHED
}
}
typedef f32x4 AccT[2][2][4][2];

constexpr float QSCL = 0.08838834764831845f * 1.4426950408889634f;
struct EpiIn {
    bf16_t *QB, *QIB, *KP, *VP, *KS, *VS, *KIP, *KIS, *U; float *WI, *out;
    __device__ __forceinline__ void operator()(const AccT& acc, const pg8::Unit& u, int wr, int wc, int fr, int fq) const {
        const int pn = u.pn, sec = pn >> 2; const bool samp = u.pm >= 128;
        const int cl = (pn & 3) * 256 + wc * 32 + 8 * fq;
#pragma unroll
        for (int ai = 0; ai < 2; ++ai)
#pragma unroll
            for (int m = 0; m < 4; ++m) {
                const int r = u.pm * 256 + ai * 128 + wr * 64 + m * 16 + fr;
                const int rs = r - TP, bs = rs >> 6, ts = rs & 63;
#pragma unroll
                for (int bj = 0; bj < 2; ++bj) {
                    const int c = cl + bj * 128; const f32x4 v0 = acc[ai][bj][m][0], v1 = acc[ai][bj][m][1];
                    if (sec == 0) { *(u32x4*)(QB + (size_t)r * 1024 + c) = pack8(v0 * QSCL, v1 * QSCL); }
                    else if (sec == 3) { *(u32x4*)(QIB + (size_t)r * 1024 + c) = pack8(v0, v1); }
                    else if (sec == 1 || sec == 2) {
                        bf16_t* bb; float* fo;
                        if (!samp) { bb = (sec == 1 ? KP : VP) + (size_t)r * 1024 + c; fo = out + (sec == 1 ? O_KP : O_VP) + (size_t)r * 1024 + c; }
                        else { bb = (sec == 1 ? KS : VS) + (size_t)(bs * SK + PAST + ts) * 1024 + c; fo = out + (sec == 1 ? O_KS : O_VS) + (size_t)rs * 1024 + c; }
                        *(u32x4*)bb = pack8(v0, v1); __builtin_nontemporal_store(v0, (f32x4*)fo); __builtin_nontemporal_store(v1, (f32x4*)(fo + 4));
                    } else if (sec == 4) {
                        *(u32x4*)(U + (size_t)r * 1024 + c) = pack8(v0, v1);
                        if (!samp) { const int t = r & (SEQ - 1); if (t >= SEQ - 15) { float* po = out + O_PP + (size_t)((r >> 13) * 15 + (t - (SEQ - 15))) * 1024 + c; __builtin_nontemporal_store(v0, (f32x4*)po); __builtin_nontemporal_store(v1, (f32x4*)(po + 4)); } }
                        else if (ts >= DSEQ - 15) { float* po = out + O_PS + (size_t)(bs * 15 + (ts - (DSEQ - 15))) * 1024 + c; __builtin_nontemporal_store(v0, (f32x4*)po); __builtin_nontemporal_store(v1, (f32x4*)(po + 4)); }
                    } else {
                        if (c < 64) {
                            bf16_t* bb; float* fo;
                            if (!samp) { const int key = r & (SEQ - 1); bb = KIP + (size_t)(r >> 13) * SEQ * 64 + (size_t)(((key >> 5) * 8 + (c >> 3)) * 32 + (key & 31)) * 8; fo = out + O_KIP + (size_t)r * 64 + c; }
                            else { const int key = PAST + ts; bb = KIS + (size_t)bs * SK * 64 + (size_t)(((key >> 5) * 8 + (c >> 3)) * 32 + (key & 31)) * 8; fo = out + O_KIS + (size_t)rs * 64 + c; }
                            *(u32x4*)bb = pack8(v0, v1); __builtin_nontemporal_store(v0, (f32x4*)fo); __builtin_nontemporal_store(v1, (f32x4*)(fo + 4));
                        } else if (c < 80) {
                            float* wo = WI + (size_t)r * 16 + (c - 64); *(f32x4*)wo = v0 * 0.03125f; *(f32x4*)(wo + 4) = v1 * 0.03125f;
                        }
                    }
                }
            }
    }
};
struct EpiPool {
    bf16_t* MIX; const float* pscale;
    __device__ __forceinline__ void operator()(const AccT& acc, const pg8::Unit& u, int wr, int wc, int fr, int fq) const {
        const int c0 = u.pn * 256 + wc * 32 + 8 * fq;
#pragma unroll
        for (int bj = 0; bj < 2; ++bj) { const int c = c0 + bj * 128; const f32x4 s0 = *(const f32x4*)(pscale + c), s1 = *(const f32x4*)(pscale + c + 4);
#pragma unroll
            for (int ai = 0; ai < 2; ++ai)
#pragma unroll
                for (int m = 0; m < 4; ++m) { const int r = u.pm * 256 + ai * 128 + wr * 64 + m * 16 + fr;
                    *(u32x4*)(MIX + (size_t)r * 2048 + 1024 + c) = pack8(acc[ai][bj][m][0] * s0, acc[ai][bj][m][1] * s1); } }
    }
};
template <int WHICH>
struct EpiRes {
    const float *xp, *xs, *mods; float* Y;
    __device__ __forceinline__ void operator()(const AccT& acc, const pg8::Unit& u, int wr, int wc, int fr, int fq) const {
        const int c0 = u.pn * 256 + wc * 32 + 8 * fq;
#pragma unroll
        for (int ai = 0; ai < 2; ++ai) {
            const int rb = u.pm * 256 + ai * 128 + wr * 64; const float* gp = mods + (size_t)modrow(rb) * MODW + (WHICH == 0 ? 2 * D : 5 * D);
#pragma unroll
            for (int bj = 0; bj < 2; ++bj) { const int c = c0 + bj * 128; const f32x4 g0 = *(const f32x4*)(gp + c), g1 = *(const f32x4*)(gp + c + 4);
#pragma unroll
                for (int m = 0; m < 4; ++m) { const int r = rb + m * 16 + fr;
                    const float* src = WHICH == 0 ? (r < TP ? xp + (size_t)r * D : xs + (size_t)(r - TP) * D) : Y + (size_t)r * D;
                    const f32x4 a0 = *(const f32x4*)(src + c), a1 = *(const f32x4*)(src + c + 4);
                    float* dst = Y + (size_t)r * D + c; *(f32x4*)dst = a0 + g0 * acc[ai][bj][m][0]; *(f32x4*)(dst + 4) = a1 + g1 * acc[ai][bj][m][1]; } }
        }
    }
};
struct EpiPart {
    float* PART;
    __device__ __forceinline__ void operator()(const AccT& acc, const pg8::Unit& u, int wr, int wc, int fr, int fq) const {
        const int slice = u.pn >> 3, c0 = (u.pn & 7) * 256 + wc * 32 + 8 * fq;
#pragma unroll
        for (int ai = 0; ai < 2; ++ai)
#pragma unroll
            for (int m = 0; m < 4; ++m) { const int r = u.pm * 256 + ai * 128 + wr * 64 + m * 16 + fr;
#pragma unroll
                for (int bj = 0; bj < 2; ++bj) { float* dst = PART + ((size_t)slice * TS + r) * D + c0 + bj * 128; *(f32x4*)dst = acc[ai][bj][m][0]; *(f32x4*)(dst + 4) = acc[ai][bj][m][1]; } }
    }
};
struct EpiGU {
    bf16_t* ACT;
    __device__ __forceinline__ void operator()(const AccT& acc, const pg8::Unit& u, int wr, int wc, int fr, int fq) const {
        const int c = u.pn * 128 + wc * 32 + 8 * fq;
#pragma unroll
        for (int ai = 0; ai < 2; ++ai)
#pragma unroll
            for (int m = 0; m < 4; ++m) { const int r = u.pm * 256 + ai * 128 + wr * 64 + m * 16 + fr; f32x4 o[2];
#pragma unroll
                for (int n = 0; n < 2; ++n) { const f32x4 gt = acc[ai][0][m][n], up = acc[ai][1][m][n];
#pragma unroll
                    for (int e = 0; e < 4; ++e) o[n][e] = gt[e] * __builtin_amdgcn_rcpf(1.0f + __builtin_amdgcn_exp2f(-1.44269504f * gt[e])) * up[e]; }
                *(u32x4*)(ACT + (size_t)r * DFF + c) = pack8(o[0], o[1]); }
    }
};

__device__ __forceinline__ int inmap(int n) { return n < 4096 ? n : (n < 4160 ? 5120 + (n - 4096) : (n < 4176 ? 5184 + (n - 4160) : 4096 + (n - 4176))); }
template <int MAP>
__device__ __forceinline__ void tr_item(const float* W, int K, int N, bf16_t* WT, int row_off, LAS float* scr, int item, int lane) {
    const int nblk = (N + 31) / 32, kb = item / nblk, nb = item % nblk, k0 = 64 * kb, n0 = 32 * nb;
    const int nsrc = n0 + (lane & 31);
    float tv[32];
#pragma unroll
    for (int i = 0; i < 32; ++i) { const int kk = 2 * i + (lane >> 5); tv[i] = nsrc < N ? W[(size_t)(k0 + kk) * N + nsrc] : 0.f; }
#pragma unroll
    for (int i = 0; i < 32; ++i) { const int kk = 2 * i + (lane >> 5); scr[kk * 33 + (lane & 31)] = tv[i]; }
    asm volatile("s_waitcnt lgkmcnt(0)" ::: "memory");
    const int c = lane & 7;
#pragma unroll
    for (int j = 0; j < 4; ++j) { const int nl = (lane >> 3) + 8 * j, n = n0 + nl; const LAS float* s = scr + (8 * c) * 33 + nl;
        u32x4 o; o.x = cvt_pk_bf16(s[0 * 33], s[1 * 33]); o.y = cvt_pk_bf16(s[2 * 33], s[3 * 33]); o.z = cvt_pk_bf16(s[4 * 33], s[5 * 33]); o.w = cvt_pk_bf16(s[6 * 33], s[7 * 33]);
        if (n < N) { int dr; if (MAP == 0) dr = row_off + n; else if (MAP == 1) dr = inmap(n); else dr = 256 * (n >> 7) + (n & 127) + (MAP == 3 ? 128 : 0);
            *(u32x4*)(WT + (size_t)dr * K + k0 + 8 * c) = o; } }
    asm volatile("s_waitcnt lgkmcnt(0)" ::: "memory");
}
__device__ __forceinline__ void cvt_cache(const float* src, bf16_t* dst, int shift, size_t n4, size_t gtid, size_t nthr) {
    for (size_t i0 = gtid; i0 < n4; i0 += 8 * nthr) {
        f32x4 v[8];
#pragma unroll
        for (int u = 0; u < 8; ++u) { const size_t i = i0 + u * nthr; v[u] = (f32x4){0.f, 0.f, 0.f, 0.f}; if (i < n4) v[u] = *(const f32x4*)(src + i * 4); }
#pragma unroll
        for (int u = 0; u < 8; ++u) { const size_t i = i0 + u * nthr; if (i < n4) { const size_t e = i * 4, b = e >> shift, rem = e & (((size_t)1 << shift) - 1); *(u32x2*)(dst + b * ((size_t)SK << (shift - 11)) + rem) = pack4(v[u]); } }
    }
}
__device__ __forceinline__ void mods_task(const Params& P, LAS unsigned char* lds, int task) {
    const int tid = threadIdx.x, w = rfl(tid >> 6), lane = tid & 63;
    LAS float* T = (LAS float*)lds;
    for (int idx = tid; idx < 12 * D; idx += NTHREADS) { const int b = idx >> 11, k = idx & (D - 1); const float c = b < 4 ? P.cp[b * D + k] : P.cs[(b - 4) * D + k]; T[k * 12 + b] = c / (1.0f + __expf(-c)); }
    __syncthreads();
    f32x2 acc[12];
#pragma unroll
    for (int b = 0; b < 12; ++b) acc[b] = (f32x2){0.f, 0.f};
    const float* wp = P.wada + (size_t)(256 * w) * MODW + task * 128 + 2 * lane;
#pragma unroll 16
    for (int k = 0; k < 256; ++k) { const f32x2 wv = *(const f32x2*)(wp + (size_t)k * MODW); const LAS f32x4* tp = (const LAS f32x4*)(T + (256 * w + k) * 12); const f32x4 t0 = tp[0], t1 = tp[1], t2 = tp[2];
        acc[0] += wv * t0[0]; acc[1] += wv * t0[1]; acc[2] += wv * t0[2]; acc[3] += wv * t0[3]; acc[4] += wv * t1[0]; acc[5] += wv * t1[1]; acc[6] += wv * t1[2]; acc[7] += wv * t1[3];
        acc[8] += wv * t2[0]; acc[9] += wv * t2[1]; acc[10] += wv * t2[2]; acc[11] += wv * t2[3]; }
    __syncthreads();
    LAS float* Pp = (LAS float*)lds;
#pragma unroll
    for (int b = 0; b < 12; ++b) *(LAS f32x2*)(Pp + (w * 12 + b) * 128 + 2 * lane) = acc[b];
    __syncthreads();
    float* mods = (float*)(P.ws + WS_MODS);
    for (int o = tid; o < 12 * 128; o += NTHREADS) { const int b = o >> 7, cc = o & 127; float s = P.bada[task * 128 + cc];
#pragma unroll
        for (int ww = 0; ww < 8; ++ww) s += Pp[(ww * 12 + b) * 128 + cc];
        mods[(size_t)b * MODW + task * 128 + cc] = s; }
    __syncthreads();
}
__device__ __forceinline__ void phase0(const Params& P, LAS unsigned char* lds, int G, int c) {
    const int tid = threadIdx.x, w = rfl(tid >> 6), lane = tid & 63;
    if (c < 96) mods_task(P, lds, c);
    for (int t = c; t < 96; t += G) if (t != c || c >= 96) mods_task(P, lds, t);
    LAS float* scr = (LAS float*)(lds + w * 16384);
    const int gw = c * NWAVES + w, NGW = G * NWAVES;
    bf16_t* WIN = (bf16_t*)(P.ws + WS_WIN); bf16_t* WOUT = (bf16_t*)(P.ws + WS_WOUT); bf16_t* WGU = (bf16_t*)(P.ws + WS_WGU); bf16_t* WDN = (bf16_t*)(P.ws + WS_WDN); bf16_t* WPL = (bf16_t*)(P.ws + WS_WPOOL);
    constexpr int I_IN = (D / 64) * ((NIN + 31) / 32), I_OUT = (D / 64) * (D / 32), I_G = (D / 64) * (DFF / 32), I_DN = (DFF / 64) * (D / 32), I_PL = 4 * (256 / 64) * (256 / 32);
    constexpr int NITEMS = I_IN + I_OUT + 2 * I_G + I_DN + I_PL;
    for (int it = gw; it < NITEMS; it += NGW) {
        int r = it;
        if (r < I_IN) { tr_item<1>(P.win, D, NIN, WIN, 0, scr, r, lane); continue; } r -= I_IN;
        if (r < I_OUT) { tr_item<0>(P.wout, D, D, WOUT, 0, scr, r, lane); continue; } r -= I_OUT;
        if (r < I_G) { tr_item<2>(P.wgate, D, DFF, WGU, 0, scr, r, lane); continue; } r -= I_G;
        if (r < I_G) { tr_item<3>(P.wup, D, DFF, WGU, 0, scr, r, lane); continue; } r -= I_G;
        if (r < I_DN) { tr_item<0>(P.wdown, DFF, D, WDN, 0, scr, r, lane); continue; } r -= I_DN;
        { const int gi = r / 32, ri = r % 32; tr_item<0>(P.wpool + (size_t)gi * 65536, 256, 256, WPL, gi * 256, scr, ri, lane); }
    }
    const size_t gtid = (size_t)c * NTHREADS + tid, nthr = (size_t)G * NTHREADS;
    cvt_cache(P.ck, (bf16_t*)(P.ws + WS_KS), 21, (size_t)NBS * PAST * AW / 4, gtid, nthr);
    cvt_cache(P.cv, (bf16_t*)(P.ws + WS_VS), 21, (size_t)NBS * PAST * AW / 4, gtid, nthr);
    { bf16_t* KIS = (bf16_t*)(P.ws + WS_KIS);
      for (size_t i = gtid; i < (size_t)NBS * PAST * IDIM / 4; i += nthr) { const size_t e = i * 4, b = e >> 17; const int rem = (int)(e & 131071), key = rem >> 6, dim = rem & 63;
          const f32x4 v = *(const f32x4*)(P.cki + e); *(u32x2*)(KIS + b * ((size_t)SK * 64) + (size_t)(((key >> 5) * 8 + (dim >> 3)) * 32 + (key & 31)) * 8 + (dim & 7)) = pack4(v); } }
}

template <int MODE>
__device__ __forceinline__ void norm_phase(const Params& P, int G, int c) {
    const int tid = threadIdx.x, w = rfl(tid >> 6), lane = tid & 63;
    const int gw = c * NWAVES + w, NGW = G * NWAVES;
    const float* mods = (const float*)(P.ws + WS_MODS); bf16_t* H = (bf16_t*)(P.ws + WS_H);
    const float* gsrc = MODE == 0 ? P.g1 : (MODE == 1 ? P.g2 : P.gf);
    for (int task = gw; task < TS + TP / 16; task += NGW) {
        const int r0 = task < TS ? TP + task : (task - TS) * 16, nrows = task < TS ? 1 : 16, mb = modrow(r0);
        f32x4 gs[8], sh[8];
#pragma unroll
        for (int j = 0; j < 8; ++j) { const int col = 4 * lane + 256 * j; gs[j] = *(const f32x4*)(gsrc + col);
            if (MODE < 2) { const float* mp = mods + (size_t)mb * MODW + (MODE == 0 ? 0 : 3 * D); sh[j] = *(const f32x4*)(mp + col); gs[j] = gs[j] * (1.0f + *(const f32x4*)(mp + D + col)); } }
#define NRM_SRC(r_) (MODE == 0 ? ((r_) < TP ? P.xp + (size_t)(r_) * D : P.xs + (size_t)((r_) - TP) * D) : P.out + (size_t)(r_) * D)
#define NRM_FIN(v_, r_) do { float ss = 0.f; _Pragma("unroll") for (int j = 0; j < 8; ++j) ss += (v_[j][0] * v_[j][0] + v_[j][1] * v_[j][1]) + (v_[j][2] * v_[j][2] + v_[j][3] * v_[j][3]); \
            const float rstd = 1.0f / sqrtf(wave_sum(ss) * (1.0f / D) + 1e-6f); \
            _Pragma("unroll") for (int j = 0; j < 8; ++j) { const int col = 4 * lane + 256 * j; \
                if (MODE < 2) { const f32x4 o = v_[j] * rstd * gs[j] + sh[j]; *(u32x2*)(H + (size_t)(r_) * D + col) = pack4(o); } \
                else { __builtin_nontemporal_store(v_[j] * rstd * gs[j], (f32x4*)(P.out + (size_t)(r_) * D + col)); } } } while (0)
        if (nrows == 1) {
            const int r = r0; const float* src = NRM_SRC(r);
            f32x4 v[8];
#pragma unroll
            for (int j = 0; j < 8; ++j) v[j] = *(const f32x4*)(src + 4 * lane + 256 * j);
            if (MODE >= 1) {
                constexpr int NSL = MODE == 1 ? 8 : 11; const float* part = (const float*)(P.ws + (MODE == 1 ? WS_PART1 : WS_PART2)) + (size_t)(r - TP) * D;
                const float* gp = mods + (size_t)mb * MODW + (MODE == 1 ? 2 * D : 5 * D);
                const float* xsrc = MODE == 1 ? P.xs + (size_t)(r - TP) * D : src;
#pragma unroll
                for (int j = 0; j < 8; ++j) { const int col = 4 * lane + 256 * j; f32x4 a = (f32x4){0.f, 0.f, 0.f, 0.f};
                    f32x4 pv[NSL];
#pragma unroll
                    for (int sl = 0; sl < NSL; ++sl) pv[sl] = *(const f32x4*)(part + (size_t)sl * TS * D + col);
#pragma unroll
                    for (int sl = 0; sl < NSL; ++sl) a += pv[sl];
                    v[j] = *(const f32x4*)(xsrc + col) + *(const f32x4*)(gp + col) * a;
                    if (MODE == 1) *(f32x4*)(P.out + (size_t)r * D + col) = v[j]; }
            }
            NRM_FIN(v, r);
        } else {
            for (int rr = 0; rr < 16; rr += 2) {
                const int ra = r0 + rr, rb = ra + 1; const float* sa = NRM_SRC(ra); const float* sb = NRM_SRC(rb);
                f32x4 va[8], vb[8];
#pragma unroll
                for (int j = 0; j < 8; ++j) { va[j] = *(const f32x4*)(sa + 4 * lane + 256 * j); vb[j] = *(const f32x4*)(sb + 4 * lane + 256 * j); }
                NRM_FIN(va, ra); NRM_FIN(vb, rb);
            }
        }
#undef NRM_SRC
#undef NRM_FIN
    }
}

#define LDU(p_) ({ const u32x2 w_ = *(const u32x2*)(p_); (f32x4){__uint_as_float(w_.x << 16), __uint_as_float(w_.x & 0xffff0000u), __uint_as_float(w_.y << 16), __uint_as_float(w_.y & 0xffff0000u)}; })
template <int W>
__device__ __forceinline__ void z_task(const Params& P, const bf16_t* U, bf16_t* Z, int r0, int col, int lane) {
    constexpr int NR = 16 + W - 1;
    const bool samp = r0 >= TP; const int t0 = samp ? ((r0 - TP) & 63) : (r0 & (SEQ - 1)); const int seq0 = r0 - t0;
    const float* spre = samp ? P.sp + (size_t)((r0 - TP) >> 6) * 15 * 1024 : nullptr;
    f32x4 x[NR];
#pragma unroll
    for (int i = 0; i < NR; ++i) { const int tt = t0 - (W - 1) + i; x[i] = (f32x4){0.f, 0.f, 0.f, 0.f};
        if (tt >= 0) x[i] = LDU(U + (size_t)(seq0 + tt) * 1024 + col); else if (samp) x[i] = *(const f32x4*)(spre + (size_t)(15 + tt) * 1024 + col); }
    f32x4 sum = (f32x4){0.f, 0.f, 0.f, 0.f};
#pragma unroll
    for (int i = 0; i < W - 1; ++i) sum += x[i];
#pragma unroll
    for (int t = 0; t < 16; ++t) {
        sum += x[t + W - 1];
        const int tt = t0 + t, cnt = samp ? W : (tt + 1 < W ? tt + 1 : W);
        *(u32x2*)(Z + (size_t)(seq0 + tt) * 1024 + col) = pack4(sum * (1.0f / (float)cnt) - x[t + W - 1]);
        sum -= x[t];
    }
}
__device__ __forceinline__ void z_phase(const Params& P, int G, int c) {
    const int tid = threadIdx.x, w = rfl(tid >> 6), lane = tid & 63;
    const int gw = c * NWAVES + w, NGW = G * NWAVES;
    const bf16_t* U = (const bf16_t*)(P.ws + WS_U); bf16_t* Z = (bf16_t*)(P.ws + WS_Z);
    for (int task = gw; task < (MT / 16) * 4; task += NGW) {
        const int grp = task & 3, r0 = (task >> 2) * 16, col = grp * 256 + 4 * lane;
        if (grp == 0) z_task<2>(P, U, Z, r0, col, lane); else if (grp == 1) z_task<4>(P, U, Z, r0, col, lane); else if (grp == 2) z_task<8>(P, U, Z, r0, col, lane); else z_task<16>(P, U, Z, r0, col, lane);
    }
}

__device__ __forceinline__ unsigned fkey(float f) { const unsigned u = __float_as_uint(f); return u ^ ((u >> 31) ? 0xFFFFFFFFu : 0x80000000u); }
#ifndef IDX_SELFCHECK
#define IDX_SELFCHECK 0
#endif
#ifndef IDX_FORCE_SLOW
#define IDX_FORCE_SLOW 0
#endif
constexpr int LCAP = 384;
constexpr int NIDX_UNITS = 1024 + 16, HQW = 1088;
__device__ __forceinline__ void hscan(const LAS unsigned* h, unsigned krem, int lane, int& digit, unsigned& above, unsigned& cnt) {
    unsigned wd[16]; unsigned cl = 0u;
#pragma unroll
    for (int i = 0; i < 16; ++i) { wd[i] = h[17 * lane + i]; cl += (wd[i] & 0xffffu) + (wd[i] >> 16); }
    unsigned incl = cl;
#pragma unroll
    for (int off = 1; off < 64; off <<= 1) { const unsigned t = __shfl_down(incl, off); if (lane + off < 64) incl += t; }
    unsigned cum = incl - cl; const bool mine = (cum < krem) && (krem <= incl);
    int dg = -1; unsigned ab = 0u, cn = 0u;
#pragma unroll
    for (int i = 15; i >= 0; --i) {
        const unsigned hi = wd[i] >> 16, lo = wd[i] & 0xffffu;
        if (dg < 0 && cum + hi >= krem) { dg = 32 * lane + 2 * i + 1; ab = cum; cn = hi; } cum += hi;
        if (dg < 0 && cum + lo >= krem) { dg = 32 * lane + 2 * i; ab = cum; cn = lo; } cum += lo;
    }
    const unsigned long long bal = __ballot(mine); const int srcl = bal ? (__ffsll((long long)bal) - 1) : 0;
    digit = __shfl(dg, srcl); above = __shfl(ab, srcl); cnt = __shfl(cn, srcl);
}
__device__ __forceinline__ void idx_phase(const Params& P, LAS unsigned char* lds, int G, int c) {
    const int tid = threadIdx.x, w = rfl(tid >> 6), lane = tid & 63, r = lane & 31, hh = lane >> 5;
    const bf16_t* QIB = (const bf16_t*)(P.ws + WS_QIB); const float* WI = (const float*)(P.ws + WS_WI);
    float* scratch = P.out + (size_t)c * (32 * 8192) + (size_t)(4 * w) * 8192;
    LAS unsigned* hist = (LAS unsigned*)(lds + w * (4 * HQW * 4));
    for (int it = 0; it * G < NIDX_UNITS; ++it) {
        const int L = snake(it, G, c); if (L >= NIDX_UNITS) continue;
        int row0, n, nend, mpitch; const bf16_t* ki; unsigned* mk;
        const bool is_p = L < 760 || L >= 776; const int Lp = L < 760 ? L : L - 16;
        if (is_p) { const int hc = 255 - (Lp >> 2), b = Lp & 3, t0 = 32 * hc; row0 = b * SEQ + t0; n = 64 * ((hc >> 1) + 1); nend = 256 * ((t0 >> 8) + 1); mpitch = 256;
            ki = (const bf16_t*)(P.ws + WS_KIP) + (size_t)b * SEQ * 64; mk = (unsigned*)(P.ws + WS_MASKP) + (size_t)row0 * 256; }
        else { const int s = L - 760, bs = s >> 1, t0 = 32 * (s & 1); row0 = TP + bs * 64 + t0; n = SK; nend = SK; mpitch = 66;
            ki = (const bf16_t*)(P.ws + WS_KIS) + (size_t)bs * SK * 64; mk = (unsigned*)(P.ws + WS_MASKS) + (size_t)(bs * 64 + t0) * 66; }
        mk += (size_t)(4 * w) * mpitch;
        bf16x8 af[2][4]; f32x4 wv[2][4];
#pragma unroll
        for (int p = 0; p < 2; ++p) { const int t = 4 * w + 2 * p + ((r >> 2) & 1), head = (r & 3) + 4 * (r >> 3);
            const bf16_t* qrow = QIB + (size_t)(row0 + t) * 1024 + head * 64 + 8 * hh;
#pragma unroll
            for (int ks = 0; ks < 4; ++ks) af[p][ks] = *(const bf16x8*)(qrow + 16 * ks);
            const float* wrow = WI + (size_t)(row0 + 4 * w + 2 * p + hh) * 16;
#pragma unroll
            for (int q = 0; q < 4; ++q) wv[p][q] = *(const f32x4*)(wrow + 4 * q); }
        const bool all = n <= 256;
        for (int rep_s = 0; rep_s < IDX_REP_SCORE; ++rep_s) {
        for (int i = lane; i < 4 * HQW; i += 64) hist[i] = 0u;
        const bf16_t* kp = ki + (size_t)lane * 8;
        bf16x8 b0[4], b1[4], c0[4], c1[4];
        const int nsub = n >> 5, nsub4 = (nsub + 3) & ~3, lim = nsub4 - 1;
#define IDX_LOAD(bb_, sub_) do { _Pragma("unroll") for (int ks = 0; ks < 4; ++ks) bb_[ks] = *(const bf16x8*)(kp + (size_t)(sub_) * 2048 + 512 * ks); } while (0)
        IDX_LOAD(b0, 0); IDX_LOAD(b1, 1);
#define IDX_TAIL(sub_, p_, acc_) do { float s0_ = 0.f, s1_ = 0.f; _Pragma("unroll") for (int i = 0; i < 16; i += 2) { s0_ += wv[p_][i >> 2][i & 3] * __builtin_amdgcn_fmed3f(acc_[i], 0.f, 3.0e38f); s1_ += wv[p_][(i + 1) >> 2][(i + 1) & 3] * __builtin_amdgcn_fmed3f(acc_[i + 1], 0.f, 3.0e38f); } \
            const float sc_ = (s0_ + s1_) + 0.0f;     \
            scratch[(size_t)(2 * (p_) + hh) * 8192 + 32 * (sub_) + r] = sc_; \
            if (!all && (sub_) < nsub) { const unsigned bn_ = fkey(sc_) >> 21; __hip_atomic_fetch_add(hist + (2 * (p_) + hh) * HQW + (bn_ >> 1) + (bn_ >> 5), 1u << (16 * (bn_ & 1)), __ATOMIC_RELAXED, __HIP_MEMORY_SCOPE_WORKGROUP); } } while (0)
#define IDX_MMA(acc_, p_, bb_) do { _Pragma("unroll") for (int i = 0; i < 16; ++i) acc_[i] = 0.f; __builtin_amdgcn_s_setprio(1); _Pragma("unroll") for (int ks = 0; ks < 4; ++ks) acc_ = __builtin_amdgcn_mfma_f32_32x32x16_bf16(af[p_][ks], bb_[ks], acc_, 0, 0, 0); __builtin_amdgcn_s_setprio(0); } while (0)
        for (int sub = 0; sub < nsub4; sub += 4) {
            f32x16 accA;
            IDX_MMA(accA, 0, b0); asm volatile("" : "+v"(accA) : : "memory"); IDX_LOAD(c0, min(sub + 2, lim)); IDX_LOAD(c1, min(sub + 3, lim)); asm volatile("" : "+v"(accA) : : "memory");
            IDX_TAIL(sub, 0, accA);
            IDX_MMA(accA, 1, b0); IDX_TAIL(sub, 1, accA);
            IDX_MMA(accA, 0, b1); IDX_TAIL(sub + 1, 0, accA);
            IDX_MMA(accA, 1, b1); IDX_TAIL(sub + 1, 1, accA);
            IDX_MMA(accA, 0, c0);
            asm volatile("" : "+v"(accA) : : "memory"); IDX_LOAD(b0, min(sub + 4, lim)); IDX_LOAD(b1, min(sub + 5, lim)); asm volatile("" : "+v"(accA) : : "memory");
            IDX_TAIL(sub + 2, 0, accA);
            IDX_MMA(accA, 1, c0); IDX_TAIL(sub + 2, 1, accA);
            IDX_MMA(accA, 0, c1); IDX_TAIL(sub + 3, 0, accA);
            IDX_MMA(accA, 1, c1); IDX_TAIL(sub + 3, 1, accA);
        }
#undef IDX_MMA
#undef IDX_TAIL
#undef IDX_LOAD
        }
        asm volatile("s_waitcnt vmcnt(0) lgkmcnt(0)" ::: "memory");
#define SC_LOAD(vv_, jb_) do { _Pragma("unroll") for (int q = 0; q < 4; ++q) _Pragma("unroll") for (int k = 0; k < 2; ++k) { const int idx_ = (jb_) + 256 * k + 4 * lane; vv_[q][k] = *(const f32x4*)(scratch + (size_t)q * 8192 + (idx_ < n ? idx_ : 0)); } } while (0)
#define KEYINV(u_) (((u_) & 0x80000000u) ? ((u_) ^ 0x80000000u) : ~(u_))
        unsigned T[4] = {0u, 0u, 0u, 0u}; unsigned pm[4]; int kr[4]; bool dn[4]; unsigned cn1[4];
        bool fast = false;
        if (!all) {
#pragma unroll
            for (int q = 0; q < 4; ++q) { int dg; unsigned ab, cn; hscan(hist + q * HQW, 256u, lane, dg, ab, cn); T[q] = (unsigned)dg << 21; pm[q] = 0xFFE00000u; kr[q] = 256 - (int)ab; dn[q] = ((int)cn == kr[q]); cn1[q] = cn; }
            fast = !IDX_FORCE_SLOW && cn1[0] <= LCAP && cn1[1] <= LCAP && cn1[2] <= LCAP && cn1[3] <= LCAP;
        }
        if (fast) {
            LAS unsigned* lst = hist; LAS unsigned* h2 = hist + 4 * LCAP * 2;
            float loF[4], hiF[4]; unsigned base[4] = {0u, 0u, 0u, 0u};
#pragma unroll
            for (int q = 0; q < 4; ++q) { const unsigned hk = T[q] + (1u << 21); loF[q] = __uint_as_float(KEYINV(T[q])); hiF[q] = hk == 0u ? __builtin_inff() : __uint_as_float(KEYINV(hk)); if (dn[q]) hiF[q] = loF[q]; }
#define CB_PROC(vv_, jb_) do { _Pragma("unroll") for (int q = 0; q < 4; ++q) _Pragma("unroll") for (int k = 0; k < 2; ++k) { const int kb_ = (jb_) + 256 * k, idx_ = kb_ + 4 * lane; unsigned nib = 0u; const bool ok_ = idx_ < n; \
                    _Pragma("unroll") for (int e = 0; e < 4; ++e) { const float x_ = vv_[q][k][e]; const bool s_ = ok_ && x_ >= hiF[q]; const bool i_ = ok_ && !s_ && x_ >= loF[q]; nib |= (s_ ? 1u : 0u) << e; \
                        const unsigned long long bal_ = __ballot(i_); if (bal_) { const unsigned pos_ = base[q] + __builtin_amdgcn_mbcnt_hi((unsigned)(bal_ >> 32), __builtin_amdgcn_mbcnt_lo((unsigned)bal_, 0u)); \
                            if (i_) { lst[(q * LCAP + pos_) * 2] = __float_as_uint(x_); lst[(q * LCAP + pos_) * 2 + 1] = (unsigned)(idx_ + e); } base[q] += (unsigned)__popcll(bal_); } } \
                    unsigned wd = nib << (4 * (lane & 7)); wd |= __shfl_xor(wd, 1); wd |= __shfl_xor(wd, 2); wd |= __shfl_xor(wd, 4); \
                    const int widx = (kb_ >> 5) + (lane >> 3); if ((lane & 7) == 0 && widx < mpitch && kb_ < nend) mk[(size_t)q * mpitch + widx] = wd; } } while (0)
            { const int nbm = ((nend + 511) >> 9) + 1 & ~1;
              f32x4 va[4][2], vb[4][2];
              SC_LOAD(va, 0);
#if IDX_SELFCHECK
              for (int bt = 0; bt < nbm; ++bt) { SC_LOAD(vb, bt * 512); CB_PROC(vb, bt * 512); } (void)va;
#else
              for (int bt = 0; bt < nbm; bt += 2) { SC_LOAD(vb, (bt + 1) * 512); CB_PROC(va, bt * 512); SC_LOAD(va, (bt + 2) * 512); CB_PROC(vb, (bt + 1) * 512); }
#endif
            }
#undef CB_PROC
            asm volatile("s_waitcnt vmcnt(0) lgkmcnt(0)" ::: "memory");
#pragma unroll
            for (int q = 0; q < 4; ++q) if (!dn[q]) {
                const int m = (int)base[q]; unsigned Tq = T[q], pmq = pm[q]; int krq = kr[q];
                for (int pass = 1; pass < 3; ++pass) {
                    const int shift = pass == 1 ? 10 : 0; const unsigned dm = pass == 1 ? 2047u : 1023u;
                    for (int i = lane; i < HQW; i += 64) h2[i] = 0u;
                    for (int i = lane; i < m; i += 64) { const unsigned u = fkey(__uint_as_float(lst[(q * LCAP + i) * 2])); if ((u & pmq) == Tq) { const unsigned bn = (u >> shift) & dm; __hip_atomic_fetch_add(h2 + (bn >> 1) + (bn >> 5), 1u << (16 * (bn & 1)), __ATOMIC_RELAXED, __HIP_MEMORY_SCOPE_WORKGROUP); } }
                    int dg; unsigned ab, cn; hscan(h2, (unsigned)krq, lane, dg, ab, cn); Tq |= (unsigned)dg << shift; pmq |= dm << shift; krq -= (int)ab;
                    if ((int)cn == krq) break;
                }
                for (int i = lane; i < m; i += 64) { const unsigned u = fkey(__uint_as_float(lst[(q * LCAP + i) * 2])); if (u >= Tq) { const unsigned ix = lst[(q * LCAP + i) * 2 + 1]; __hip_atomic_fetch_or(mk + (size_t)q * mpitch + (ix >> 5), 1u << (ix & 31u), __ATOMIC_RELAXED, __HIP_MEMORY_SCOPE_AGENT); } }
            }
        } else {
            if (!all) {
                for (int pass = 1; pass < 3; ++pass) {
                    if (dn[0] && dn[1] && dn[2] && dn[3]) break;
                    const int shift = pass == 1 ? 10 : 0; const unsigned dm = pass == 1 ? 2047u : 1023u;
                    for (int i = lane; i < 4 * HQW; i += 64) hist[i] = 0u;
#define P2_PROC(vv_, jb_) do { _Pragma("unroll") for (int q = 0; q < 4; ++q) _Pragma("unroll") for (int k = 0; k < 2; ++k) { const int idx_ = (jb_) + 256 * k + 4 * lane; \
                    if (!dn[q] && idx_ < n) { _Pragma("unroll") for (int e = 0; e < 4; ++e) { const unsigned u = fkey(vv_[q][k][e]); \
                        if ((u & pm[q]) == T[q]) { const unsigned bn = (u >> shift) & dm; __hip_atomic_fetch_add(hist + q * HQW + (bn >> 1) + (bn >> 5), 1u << (16 * (bn & 1)), __ATOMIC_RELAXED, __HIP_MEMORY_SCOPE_WORKGROUP); } } } } } while (0)
                    { const int nb2 = ((n + 511) >> 9) + 1 & ~1;
                      f32x4 va[4][2], vb[4][2];
                      SC_LOAD(va, 0);
                      for (int bt = 0; bt < nb2; bt += 2) { SC_LOAD(vb, (bt + 1) * 512); P2_PROC(va, bt * 512); SC_LOAD(va, (bt + 2) * 512); P2_PROC(vb, (bt + 1) * 512); } }
#undef P2_PROC
#pragma unroll
                    for (int q = 0; q < 4; ++q) if (!dn[q]) { int dg; unsigned ab, cn; hscan(hist + q * HQW, (unsigned)kr[q], lane, dg, ab, cn); T[q] |= (unsigned)dg << shift; pm[q] |= dm << shift; kr[q] -= (int)ab; dn[q] = ((int)cn == kr[q]); }
                }
            }
            float Tf[4];
#pragma unroll
            for (int q = 0; q < 4; ++q) Tf[q] = all ? -__builtin_inff() : __uint_as_float(KEYINV(T[q]));
#define MK_PROC(vv_, jb_) do { _Pragma("unroll") for (int q = 0; q < 4; ++q) _Pragma("unroll") for (int k = 0; k < 2; ++k) { const int kb_ = (jb_) + 256 * k, idx_ = kb_ + 4 * lane; unsigned nib = 0u; \
                    _Pragma("unroll") for (int e = 0; e < 4; ++e) nib |= (vv_[q][k][e] >= Tf[q] ? 1u : 0u) << e; \
                    unsigned wd = (idx_ < n ? nib : 0u) << (4 * (lane & 7)); wd |= __shfl_xor(wd, 1); wd |= __shfl_xor(wd, 2); wd |= __shfl_xor(wd, 4); \
                    const int widx = (kb_ >> 5) + (lane >> 3); if ((lane & 7) == 0 && widx < mpitch && kb_ < nend) mk[(size_t)q * mpitch + widx] = wd; } } while (0)
            for (int rep_m = 0; rep_m < IDX_REP_MASK; ++rep_m) {
                const int nbm = ((nend + 511) >> 9) + 1 & ~1;
                f32x4 va[4][2], vb[4][2];
                SC_LOAD(va, 0);
                for (int bt = 0; bt < nbm; bt += 2) { SC_LOAD(vb, (bt + 1) * 512); MK_PROC(va, bt * 512); SC_LOAD(va, (bt + 2) * 512); MK_PROC(vb, (bt + 1) * 512); }
            }
#undef MK_PROC
        }
#undef SC_LOAD
#undef KEYINV
#if IDX_SELFCHECK
        asm volatile("s_waitcnt vmcnt(0) lgkmcnt(0)" ::: "memory");
#pragma unroll 1
        for (int q = 0; q < 4; ++q) {
            int cnt = 0; float smin = __builtin_inff(), umax = -__builtin_inff();
            for (int j = lane; j < nend; j += 64) {
                const unsigned wdv = __hip_atomic_load(mk + (size_t)q * mpitch + (j >> 5), __ATOMIC_RELAXED, __HIP_MEMORY_SCOPE_AGENT); const bool sel = (wdv >> (j & 31)) & 1u;
                if (j < n) { const float x = __hip_atomic_load(scratch + (size_t)q * 8192 + j, __ATOMIC_RELAXED, __HIP_MEMORY_SCOPE_AGENT); if (sel) { ++cnt; smin = fminf(smin, x); } else umax = fmaxf(umax, x); }
                else if (sel) ++cnt;
            }
#pragma unroll
            for (int o = 1; o < 64; o <<= 1) { cnt += __shfl_xor(cnt, o); smin = fminf(smin, __shfl_xor(smin, o)); umax = fmaxf(umax, __shfl_xor(umax, o)); }
            const int want = n < 256 ? n : 256;
            if (lane == 0 && (cnt != want || !(smin >= umax))) __hip_atomic_fetch_add((unsigned*)P.ws + 4000, 1u, __ATOMIC_RELAXED, __HIP_MEMORY_SCOPE_AGENT);
        }
#endif
    }
}

constexpr int NATT_UNITS = 1024 + 64;
__device__ __forceinline__ void attn_phase(const Params& P, LAS unsigned char* lds, int G, int c) {
    const int tid = threadIdx.x, w = rfl(tid >> 6), lane = tid & 63, l15 = lane & 15, g = lane >> 4;
    const bf16_t* QB = (const bf16_t*)(P.ws + WS_QB); bf16_t* MIX = (bf16_t*)(P.ws + WS_MIX);
    constexpr unsigned KOFF = 0u, VOFF = 65536u;
    const int srow = (w * 64 + lane) >> 4, spc = lane & 15;
    const int kch = spc ^ (srow & 15), vch = spc ^ (2 * (srow & 7));
    for (int it = 0; it * G < NATT_UNITS; ++it) {
        const int L = snake(it, G, c); if (L >= NATT_UNITS) continue;
        int row0, nq, ntiles, mpitch, h; const bf16_t *Kb, *Vb; const unsigned* mk;
        const bool is_p = L < 768 || L >= 832; const int Lp = L < 768 ? L : L - 64;
        if (is_p) { const int qb = 31 - (Lp >> 5), bh = Lp & 31, b = bh >> 3; h = bh & 7; row0 = b * SEQ + 256 * qb; nq = 256; ntiles = 4 * (qb + 1); mpitch = 256;
            Kb = (const bf16_t*)(P.ws + WS_KP) + (size_t)b * SEQ * 1024; Vb = (const bf16_t*)(P.ws + WS_VP) + (size_t)b * SEQ * 1024; mk = (const unsigned*)(P.ws + WS_MASKP) + (size_t)row0 * 256; }
        else { const int s = L - 768, bs = s >> 3; h = s & 7; row0 = TP + bs * 64; nq = 64; ntiles = SK / 64; mpitch = 66;
            Kb = (const bf16_t*)(P.ws + WS_KS) + (size_t)bs * SK * 1024; Vb = (const bf16_t*)(P.ws + WS_VS) + (size_t)bs * SK * 1024; mk = (const unsigned*)(P.ws + WS_MASKS) + (size_t)(bs * 64) * 66; }
        const bool active = 32 * w < nq;
        bf16x8 qf[2][4]; f32x4 O[2][9]; float mrun[2]; const unsigned* mrow[2];
        const bf16x8 ones = (bf16x8){0x3F80, 0x3F80, 0x3F80, 0x3F80, 0x3F80, 0x3F80, 0x3F80, 0x3F80};
#pragma unroll
        for (int qs = 0; qs < 2; ++qs) { mrun[qs] = -1e20f; const int ql = active ? 32 * w + 16 * qs + l15 : 0; mrow[qs] = mk + (size_t)ql * mpitch;
#pragma unroll
            for (int ks = 0; ks < 4; ++ks) qf[qs][ks] = *(const bf16x8*)(QB + (size_t)(row0 + ql) * 1024 + h * 128 + 32 * ks + 8 * g);
#pragma unroll
            for (int cc = 0; cc < 9; ++cc) O[qs][cc] = (f32x4){0.f, 0.f, 0.f, 0.f}; }
        const bf16_t* kg = Kb + (size_t)srow * 1024 + h * 128 + kch * 8; const bf16_t* vg = Vb + (size_t)srow * 1024 + h * 128 + vch * 8;
#define ATT_STAGE(kt_, buf_) do { const size_t go_ = (size_t)(64 * (kt_)) * 1024; LAS unsigned char* kd_ = lds + KOFF + (buf_) * 32768u + (unsigned)((kt_) & 1) * 16384u + (unsigned)w * 1024u; LAS unsigned char* vd_ = lds + VOFF + (buf_) * 32768u + (unsigned)((kt_) & 1) * 16384u + (unsigned)w * 1024u; \
            __builtin_amdgcn_global_load_lds((const unsigned*)(kg + go_), (LAS unsigned*)kd_, 16, 0, 0); __builtin_amdgcn_global_load_lds((const unsigned*)(kg + go_ + 32 * 1024), (LAS unsigned*)(kd_ + 8192), 16, 0, 0); \
            __builtin_amdgcn_global_load_lds((const unsigned*)(vg + go_), (LAS unsigned*)vd_, 16, 0, 0); __builtin_amdgcn_global_load_lds((const unsigned*)(vg + go_ + 32 * 1024), (LAS unsigned*)(vd_ + 8192), 16, 0, 0); } while (0)
        ATT_STAGE(0, 0u); if (ntiles > 1) ATT_STAGE(1, 0u);
        asm volatile("s_waitcnt vmcnt(0)" ::: "memory"); __syncthreads();
        for (int kt = 0; kt < ntiles; ++kt) {
            const unsigned sbuf = (unsigned)((kt >> 1) & 1);
            const unsigned kb = KOFF + sbuf * 32768u + (unsigned)(kt & 1) * 16384u, vb = VOFF + sbuf * 32768u + (unsigned)(kt & 1) * 16384u;
            if ((kt & 1) == 0) { if (kt + 2 < ntiles) ATT_STAGE(kt + 2, sbuf ^ 1u); if (kt + 3 < ntiles) ATT_STAGE(kt + 3, sbuf ^ 1u); }
            if (active) {
                f32x4 S[2][4];
#pragma unroll
                for (int qs = 0; qs < 2; ++qs)
#pragma unroll
                    for (int sub = 0; sub < 4; ++sub) S[qs][sub] = (f32x4){0.f, 0.f, 0.f, 0.f};
                __builtin_amdgcn_s_setprio(1);
#pragma unroll
                for (int sub = 0; sub < 4; ++sub)
#pragma unroll
                    for (int ks = 0; ks < 4; ++ks) { const bf16x8 kf = *(const LAS bf16x8*)(lds + kb + (16 * sub + l15) * 256 + (((4 * ks + g) ^ l15) * 16));
#pragma unroll
                        for (int qs = 0; qs < 2; ++qs) S[qs][sub] = __builtin_amdgcn_mfma_f32_16x16x32_bf16(kf, qf[qs][ks], S[qs][sub], 0, 0, 0); }
                __builtin_amdgcn_s_setprio(0);
                bf16x8 pf[2][2];
#pragma unroll
                for (int qs = 0; qs < 2; ++qs) {
                    const u32x2 mw = *(const u32x2*)(mrow[qs] + 2 * kt);
                    const unsigned m0 = mw.x >> (4 * g), m1 = mw.y >> (4 * g);
                    float sv[4][4]; float mx = -1e30f;
#pragma unroll
                    for (int sub = 0; sub < 4; ++sub)
#pragma unroll
                        for (int i = 0; i < 4; ++i) { const unsigned word = (sub >> 1) ? m1 : m0; const unsigned t = (unsigned)__builtin_amdgcn_sbfe((int)word, 16 * (sub & 1) + i, 1);
                            sv[sub][i] = __uint_as_float((__float_as_uint(S[qs][sub][i]) & t) | (0xF149F2CAu & ~t));     mx = fmaxf(mx, sv[sub][i]); }
                    mx = fmaxf(mx, __shfl_xor(mx, 16)); mx = fmaxf(mx, __shfl_xor(mx, 32));
                    if (__any(mx > mrun[qs] + 8.0f)) {
                        const float mnew_ = fmaxf(mrun[qs], mx); const float alpha = __builtin_amdgcn_exp2f(mrun[qs] - mnew_);
#pragma unroll
                        for (int cc = 0; cc < 9; ++cc) O[qs][cc] = O[qs][cc] * alpha;
                        mrun[qs] = mnew_;
                    }
                    const float mnew = mrun[qs];
                    f32x4 pp[4];
#pragma unroll
                    for (int sub = 0; sub < 4; ++sub)
#pragma unroll
                        for (int i = 0; i < 4; ++i) pp[sub][i] = __builtin_amdgcn_exp2f(sv[sub][i] - mnew);
#pragma unroll
                    for (int k2 = 0; k2 < 2; ++k2) { const u32x4 pw = pack8(pp[2 * k2], pp[2 * k2 + 1]); pf[qs][k2] = __builtin_bit_cast(bf16x8, pw); }
                }
                const int vxh = 4 * (g & 1) + (l15 >> 2);
                __builtin_amdgcn_s_setprio(1);
                const LAS unsigned char* vp = lds + vb + (4 * g + (l15 >> 2)) * 256 + ((lane >> 1) & 1) * 16 + (lane & 1) * 8;
#pragma unroll
                for (int cc = 0; cc < 8; ++cc)
#pragma unroll
                    for (int k2 = 0; k2 < 2; ++k2) {
                        const s16x4 va = __builtin_amdgcn_ds_read_tr16_b64_v4i16((LAS s16x4*)(vp + (32 * k2) * 256 + ((cc ^ vxh) * 32)));
                        const s16x4 vbv = __builtin_amdgcn_ds_read_tr16_b64_v4i16((LAS s16x4*)(vp + (32 * k2 + 16) * 256 + ((cc ^ vxh) * 32)));
                        const bf16x8 vf = (bf16x8){va[0], va[1], va[2], va[3], vbv[0], vbv[1], vbv[2], vbv[3]};
#pragma unroll
                        for (int qs = 0; qs < 2; ++qs) O[qs][cc] = __builtin_amdgcn_mfma_f32_16x16x32_bf16(vf, pf[qs][k2], O[qs][cc], 0, 0, 0);
                    }
#pragma unroll
                for (int k2 = 0; k2 < 2; ++k2)
#pragma unroll
                    for (int qs = 0; qs < 2; ++qs) O[qs][8] = __builtin_amdgcn_mfma_f32_16x16x32_bf16(ones, pf[qs][k2], O[qs][8], 0, 0, 0);
                __builtin_amdgcn_s_setprio(0);
            }
            if ((kt & 1) || kt + 1 == ntiles) { asm volatile("s_waitcnt vmcnt(0)" ::: "memory"); __syncthreads(); }
        }
#undef ATT_STAGE
        if (active) {
#pragma unroll
            for (int qs = 0; qs < 2; ++qs) { const float inv = 1.0f / O[qs][8][0];
                bf16_t* orow = MIX + (size_t)(row0 + 32 * w + 16 * qs + l15) * 2048 + h * 128 + 4 * g;
#pragma unroll
                for (int cc = 0; cc < 8; ++cc) *(u32x2*)(orow + 16 * cc) = pack4(O[qs][cc] * inv); }
        }
    }
}


#define XB_TMO      128
#define XB_XCNT(j)  (256  + 64 * (j))
#define XB_XSUB(j)  (1280 + 64 * (j))
#define XB_XGEN(j)  (2304 + 64 * (j))
#define XB_TOP      3328
#define XB_TOPGEN   3392
#define XCD_BAR_WORDS 3456
#define XB_SPIN_CAP (1u << 20)
__device__ __forceinline__ unsigned xb_ld(unsigned* p)              { return __hip_atomic_load(p, __ATOMIC_RELAXED, __HIP_MEMORY_SCOPE_AGENT); }
__device__ __forceinline__ unsigned xb_add(unsigned* p, unsigned v) { return __hip_atomic_fetch_add(p, v, __ATOMIC_RELAXED, __HIP_MEMORY_SCOPE_AGENT); }
__device__ __forceinline__ unsigned xb_xcc_id() { return (unsigned)__builtin_amdgcn_s_getreg((3 << 11) | 20) & 0xFu; }
#define XB_SPIN(cond, bar) do { unsigned _sp = 0; while (cond) { __builtin_amdgcn_s_sleep(1); \
    if ((++_sp & 255u) == 0u) { if (xb_ld(&(bar)[XB_TMO])) break; if (_sp > XB_SPIN_CAP) { atomicAdd(&(bar)[XB_TMO], 1u); break; } } } } while (0)
struct XcdBarrier { unsigned* bar; unsigned x; volatile LAS unsigned* st; };
__device__ __forceinline__ XcdBarrier xcd_barrier_post(unsigned* bar, volatile LAS unsigned* st) {
    XcdBarrier b; b.bar = bar; b.x = xb_xcc_id(); b.st = st;
    if (threadIdx.x == 0) (void)xb_add(&bar[XB_XCNT(b.x)], 1u);
    return b;
}
__device__ __forceinline__ void xcd_barrier_complete(unsigned* bar, unsigned x, unsigned& nloc, unsigned& nx) {
    const unsigned G = gridDim.x * gridDim.y * gridDim.z;
    unsigned sum, cnt, mine, sp = 0u;
    for (;;) {
        sum = 0u; cnt = 0u; mine = 0u;
#pragma unroll
        for (unsigned j = 0; j < 16; ++j) { const unsigned c = xb_ld(&bar[XB_XCNT(j)]); sum += c; cnt += (c > 0u) ? 1u : 0u; mine = (j == x) ? c : mine; }
        if (sum == G) break;
        __builtin_amdgcn_s_sleep(1);
        if ((++sp & 255u) == 0u) { if (xb_ld(&bar[XB_TMO])) break; if (sp > XB_SPIN_CAP) { atomicAdd(&bar[XB_TMO], 1u); break; } }
    }
    nloc = mine > 0u ? mine : 1u; nx = cnt > 0u ? cnt : 1u;
}
__device__ __forceinline__ void xcd_barrier(const XcdBarrier& b) {
    asm volatile("s_waitcnt vmcnt(0)" ::: "memory");
    __syncthreads();
    if (threadIdx.x == 0) {
        unsigned* bar = b.bar;
        __builtin_amdgcn_s_waitcnt(0);
        unsigned nloc = b.st[0], nx = b.st[1];
        if (nloc == 0u) { xcd_barrier_complete(bar, b.x, nloc, nx); b.st[0] = nloc; b.st[1] = nx; }
        const unsigned old = xb_add(&bar[XB_XSUB(b.x)], 1u);
        const unsigned gen = old / nloc;
        if (old + 1u == (gen + 1u) * nloc) {
            __builtin_amdgcn_fence(__ATOMIC_RELEASE, "agent");
            asm volatile("s_waitcnt vmcnt(0)" ::: "memory");
            const unsigned og = xb_add(&bar[XB_TOP], 1u);
            const unsigned tg = og / nx;
            if (og + 1u == (tg + 1u) * nx) xb_add(&bar[XB_TOPGEN], 1u);
            else XB_SPIN(xb_ld(&bar[XB_TOPGEN]) == tg, bar);
            __builtin_amdgcn_fence(__ATOMIC_ACQUIRE, "agent");
            xb_add(&bar[XB_XGEN(b.x)], 1u);
            asm volatile("s_waitcnt vmcnt(0)" ::: "memory");
        } else {
            XB_SPIN(xb_ld(&bar[XB_XGEN(b.x)]) == gen, bar);
            __builtin_amdgcn_fence(__ATOMIC_ACQUIRE, "agent");
            asm volatile("s_waitcnt vmcnt(0)" ::: "memory");
        }
    }
    __syncthreads();
}

__global__ void __launch_bounds__(NTHREADS) fwd_kernel(Params P) {
    extern __shared__ __attribute__((aligned(16))) unsigned char lds_raw[];
    LAS unsigned char* lds = (LAS unsigned char*)lds_raw;
    const int G = gridDim.x, c = blockIdx.x;
    const int lo = P.lo, hi = P.hi;
#define IN(k) (lo <= (k) && (k) < hi)
#define REP(k) for (int rep_ = 0; rep_ < ((k) == DUP_PHASE ? 2 : 1); ++rep_)
#define SEAM(k) do { if (IN(k) && IN((k) + 1)) { if ((k) == 0) { cg::this_grid().sync(); bar = xcd_barrier_post((unsigned*)P.ws, bst); } else xcd_barrier(bar); } } while (0)
    volatile LAS unsigned* bst = (volatile LAS unsigned*)(lds + 139264);
    if (threadIdx.x < 2) bst[threadIdx.x] = 0u;
    if (c == 0 && N_LAUNCH == 1) for (int i = threadIdx.x; i < 4096; i += NTHREADS) ((unsigned*)P.ws)[i] = 0u;
    __syncthreads();
    XcdBarrier bar; bar.bar = (unsigned*)P.ws; bar.x = 0; bar.st = bst;
    bf16_t* H = (bf16_t*)(P.ws + WS_H); bf16_t* MIX = (bf16_t*)(P.ws + WS_MIX); const float* mods = (const float*)(P.ws + WS_MODS);
    if (IN(0)) REP(0) phase0(P, lds, G, c);
    SEAM(0);
    if (IN(1)) REP(1) norm_phase<0>(P, G, c);
    SEAM(1);
    if (IN(2)) REP(2) {
        pg8::Gemm g{H, (const bf16_t*)(P.ws + WS_WIN), MT, NINP, D, D, D, 0, 30, 0}; pg8::StaticOrder S; S.init(MT, NINP, G, c);
        EpiIn E{(bf16_t*)(P.ws + WS_QB), (bf16_t*)(P.ws + WS_QIB), (bf16_t*)(P.ws + WS_KP), (bf16_t*)(P.ws + WS_VP), (bf16_t*)(P.ws + WS_KS), (bf16_t*)(P.ws + WS_VS),
                (bf16_t*)(P.ws + WS_KIP), (bf16_t*)(P.ws + WS_KIS), (bf16_t*)(P.ws + WS_U), (float*)(P.ws + WS_WI), P.out};
        pg8::gemm_phase<EpiIn, false>(lds, g, S, E);
    }
    SEAM(2);
    if (IN(3)) { REP(3) idx_phase(P, lds, G, c); z_phase(P, G, c); }
    SEAM(3);
    if (IN(4)) {
        REP(4) attn_phase(P, lds, G, c);
        pg8::Gemm g{(const bf16_t*)(P.ws + WS_Z), (const bf16_t*)(P.ws + WS_WPOOL), MT, 1024, 256, 1024, 256, 512, 30, 0}; pg8::StaticOrder S; S.init(MT, 1024, G, c);
        EpiPool E{MIX, P.pscale};
        pg8::gemm_phase(lds, g, S, E);
    }
    SEAM(4);
    if (IN(5)) REP(5) {
        pg8::Gemm g{MIX, (const bf16_t*)(P.ws + WS_WOUT), TP, D, D, D, D, 0, 30, 0}; pg8::StaticOrder S; S.init(TP, D, G, c);
        EpiRes<0> E{P.xp, P.xs, mods, P.out};
        pg8::gemm_phase(lds, g, S, E);
        pg8::Gemm g2{MIX + (size_t)TP * D, (const bf16_t*)(P.ws + WS_WOUT), TS, D * 8, 256, D, D, 0, 3, 512}; pg8::StaticOrder S2; S2.init(TS, D * 8, G, c);
        EpiPart E2{(float*)(P.ws + WS_PART1)};
        pg8::gemm_phase(lds, g2, S2, E2);
    }
    SEAM(5);
    if (IN(6)) REP(6) norm_phase<1>(P, G, c);
    SEAM(6);
    if (IN(7)) REP(7) {
        pg8::Gemm g{H, (const bf16_t*)(P.ws + WS_WGU), MT, 2 * DFF, D, D, D, 0, 30, 0}; pg8::StaticOrder S; S.init(MT, 2 * DFF, G, c);
        EpiGU E{(bf16_t*)(P.ws + WS_ACT)};
        pg8::gemm_phase(lds, g, S, E);
    }
    SEAM(7);
    if (IN(8)) {
        pg8::Gemm g{(const bf16_t*)(P.ws + WS_ACT), (const bf16_t*)(P.ws + WS_WDN), TP, D, DFF, DFF, DFF, 0, 30, 0}; pg8::StaticOrder S; S.init(TP, D, G, c);
        EpiRes<1> E{P.xp, P.xs, mods, P.out};
        pg8::gemm_phase(lds, g, S, E);
        pg8::Gemm g2{(const bf16_t*)(P.ws + WS_ACT) + (size_t)TP * DFF, (const bf16_t*)(P.ws + WS_WDN), TS, D * 11, 512, DFF, DFF, 0, 3, 1024}; pg8::StaticOrder S2; S2.init(TS, D * 11, G, c);
        EpiPart E2{(float*)(P.ws + WS_PART2)};
        pg8::gemm_phase(lds, g2, S2, E2);
    }
    SEAM(8);
    if (IN(9)) norm_phase<2>(P, G, c);
#if IDX_SELFCHECK
    if (IN(9) && c == 0 && threadIdx.x == 0) { asm volatile("s_waitcnt vmcnt(0)" ::: "memory"); if (__hip_atomic_load((unsigned*)P.ws + 4000, __ATOMIC_RELAXED, __HIP_MEMORY_SCOPE_AGENT) != 0u) P.out[0] = __builtin_nanf(""); }
#endif
#undef IN
#undef SEAM
}

extern "C" void kernel_launch(void* const* d_in, const int* in_sizes, int n_in, void* d_out, int out_size, void* d_ws, size_t ws_size, hipStream_t stream) {
    static int grid = 0;
    if (grid == 0) {
        if (n_in != 20 || (size_t)out_size != O_END || ws_size < WS_END) { fprintf(stderr, "kernel_launch: unexpected shapes (n_in %d, out %d, ws %zu)\n", n_in, out_size, ws_size); grid = -1; return; }
        int dev = 0, cus = 0, per_cu = 0;
        hipGetDevice(&dev); hipDeviceGetAttribute(&cus, hipDeviceAttributeMultiprocessorCount, dev);
        if (hipFuncSetAttribute((const void*)fwd_kernel, hipFuncAttributeMaxDynamicSharedMemorySize, LDS_BYTES) != hipSuccess) { fprintf(stderr, "kernel_launch: hipFuncSetAttribute failed\n"); grid = -1; return; }
        if (hipOccupancyMaxActiveBlocksPerMultiprocessor(&per_cu, (const void*)fwd_kernel, NTHREADS, LDS_BYTES) != hipSuccess || per_cu < 1) { fprintf(stderr, "kernel_launch: occupancy query says %d blocks per CU\n", per_cu); per_cu = 1; }
        (void)hipGetLastError();
        grid = cus * per_cu; if (grid > 256) grid = 256;
    }
    if (grid < 0) return;
    Params p{};
    const float** pp = (const float**)&p;
    for (int i = 0; i < 20; ++i) pp[i] = (const float*)d_in[i];
    p.out = (float*)d_out; p.ws = (unsigned char*)d_ws;
    if (N_LAUNCH == 1) {
        p.lo = 0; p.hi = 10;
        void* args[] = {&p};
        hipError_t e = hipLaunchCooperativeKernel((const void*)fwd_kernel, dim3(grid), dim3(NTHREADS), args, LDS_BYTES, stream);
        if (e != hipSuccess) fprintf(stderr, "cooperative launch failed: %s (grid %d)\n", hipGetErrorString(e), grid);
    } else {
        for (int k = 0; k < 10; ++k) { p.lo = k; p.hi = k + 1; hipLaunchKernelGGL(fwd_kernel, dim3(grid), dim3(NTHREADS), LDS_BYTES, stream, p); }
    }
}
```

```cpp
#include <hip/hip_runtime.h>
#include <hip/hip_cooperative_groups.h>
#include <cstdio>
#include <cstdint>
namespace cg = cooperative_groups;

#ifndef N_LAUNCH
#define N_LAUNCH 1
#endif
#ifndef IDX_REP_SCORE
#define IDX_REP_SCORE 1
#endif
#ifndef IDX_REP_MASK
#define IDX_REP_MASK 1
#endif
#ifndef DUP_PHASE
#define DUP_PHASE -1
#endif

#define LAS __attribute__((address_space(3)))
typedef unsigned short bf16_t;
typedef short bf16x8 __attribute__((ext_vector_type(8)));
typedef short s16x4 __attribute__((ext_vector_type(4)));
typedef float f32x2 __attribute__((ext_vector_type(2)));
typedef float f32x4 __attribute__((ext_vector_type(4)));
typedef float f32x16 __attribute__((ext_vector_type(16)));
typedef unsigned u32x2 __attribute__((ext_vector_type(2)));
typedef unsigned u32x4 __attribute__((ext_vector_type(4)));

constexpr int D = 2048, NBP = 4, SEQ = 8192, TP = NBP * SEQ, NBS = 8, DSEQ = 64, TS = NBS * DSEQ, MT = TP + TS;
constexpr int PAST = 2048, SK = PAST + DSEQ, AW = 1024, HD = 128, IDIM = 64, DFF = 5632, NIN = 5200, NINP = 5376;
constexpr int MODW = 6 * D;
constexpr int NTHREADS = 512, NWAVES = 8;
constexpr size_t O_KP = (size_t)MT * D;
constexpr size_t O_VP = O_KP + (size_t)TP * AW;
constexpr size_t O_KIP = O_VP + (size_t)TP * AW;
constexpr size_t O_PP = O_KIP + (size_t)TP * IDIM;
constexpr size_t O_KS = O_PP + (size_t)NBP * 15 * 1024;
constexpr size_t O_VS = O_KS + (size_t)TS * AW;
constexpr size_t O_KIS = O_VS + (size_t)TS * AW;
constexpr size_t O_PS = O_KIS + (size_t)TS * IDIM;
constexpr size_t O_END = O_PS + (size_t)NBS * 15 * 1024;
constexpr size_t MiB = 1u << 20;
constexpr size_t WS_MODS = 1 * MiB, WS_WIN = 2 * MiB, WS_WOUT = 23 * MiB, WS_WGU = 31 * MiB, WS_WDN = 75 * MiB, WS_WPOOL = 97 * MiB;
constexpr size_t WS_KIP = 98 * MiB, WS_KIS = 102 * MiB, WS_WI = 105 * MiB, WS_MASKP = 108 * MiB, WS_MASKS = 140 * MiB;
constexpr size_t WS_QB = 141 * MiB, WS_QIB = 206 * MiB, WS_KP = 271 * MiB, WS_VP = 335 * MiB, WS_KS = 399 * MiB, WS_VS = 432 * MiB;
constexpr size_t WS_PART1 = 500 * MiB, WS_PART2 = 540 * MiB;
constexpr size_t WS_U = 465 * MiB, WS_Z = 595 * MiB, WS_H = 660 * MiB, WS_MIX = 790 * MiB, WS_ACT = 141 * MiB, WS_END = 920 * MiB;
static_assert(WS_ACT + (size_t)MT * DFF * 2 <= WS_PART1 && WS_PART1 + (size_t)8 * TS * D * 4 <= WS_PART2 && WS_PART2 + (size_t)11 * TS * D * 4 <= WS_Z, "ACT overlay / partials");
constexpr int LDS_BYTES = 139264 + 64;

struct Params {
    const float *xp, *xs, *cp, *cs, *ck, *cv, *cki, *sp, *wada, *bada, *g1, *win, *wpool, *pscale, *wout, *g2, *wgate, *wup, *wdown, *gf;
    float* out; unsigned char* ws; int lo, hi;
};

__device__ __forceinline__ int rfl(int v) { return __builtin_amdgcn_readfirstlane(v); }
__device__ __forceinline__ unsigned cvt_pk_bf16(float lo, float hi) { unsigned r; asm volatile("v_cvt_pk_bf16_f32 %0, %1, %2" : "=v"(r) : "v"(lo), "v"(hi)); return r; }
__device__ __forceinline__ u32x4 pack8(f32x4 a, f32x4 b) { u32x4 w; w.x = cvt_pk_bf16(a[0], a[1]); w.y = cvt_pk_bf16(a[2], a[3]); w.z = cvt_pk_bf16(b[0], b[1]); w.w = cvt_pk_bf16(b[2], b[3]); return w; }
__device__ __forceinline__ u32x2 pack4(f32x4 a) { u32x2 w; w.x = cvt_pk_bf16(a[0], a[1]); w.y = cvt_pk_bf16(a[2], a[3]); return w; }
__device__ __forceinline__ float wave_sum(float v) {
#pragma unroll
    for (int o = 1; o < 64; o <<= 1) v += __shfl_xor(v, o);
    return v;
}
__device__ __forceinline__ int snake(int it, int G, int c) { return it * G + ((it & 1) ? (G - 1 - c) : c); }
__device__ __forceinline__ int modrow(int r) { return r < TP ? (r >> 13) : 4 + ((r - TP) >> 6); }

namespace pg8 {
constexpr int BM = 256, BK = 64, HALF = 128, HTB = HALF * BK * 2, STAGE_BYTES = 8 * HTB, NXCD = 8, WGM = 4;
__host__ __device__ __forceinline__ int lds_byte(int r, int c) { const int st = (r >> 4) * 2 + (c >> 5), rr = r & 15, cc = c & 31, ob = rr * 64 + cc * 2; return st * 1024 + (ob ^ (((ob >> 9) & 1) << 5)); }
__host__ __device__ __forceinline__ void stage_rc(int b, int& R, int& C) { const int st = b / 1024, sb = b % 1024, swz = sb ^ (((sb >> 9) & 1) << 5); R = (st >> 1) * 16 + swz / 64; C = (st & 1) * 32 + (swz % 64) / 2; }
__host__ __device__ __forceinline__ int perm32(int rho) { const int n = rho >> 4, i = rho & 15; return 8 * (i >> 2) + 4 * n + (i & 3); }
struct Unit { int pm, pn; };
struct Gemm { const bf16_t* A; const bf16_t* Bt; int M, N, K, lda, ldb; size_t a_pn_step; int ks_shift; size_t ks_bytes; };
struct StaticOrder {
    int nM, nN, nwg, G, c;
    __host__ __device__ void init(int M, int N, int G_, int c_) { nM = M / BM; nN = N / BM; nwg = nM * nN; G = G_; c = c_; }
    __host__ __device__ bool next(int i, Unit& u) const {
        const long L = (long)i * G + c; if (L >= nwg) return false;
        int wgid = (int)L; { const int q = nwg / NXCD, r = nwg % NXCD, xcd = wgid % NXCD, off = wgid / NXCD; wgid = (xcd < r ? xcd * (q + 1) : r * (q + 1) + (xcd - r) * q) + off; }
        const int nig = WGM * nN, gid = wgid / nig, fm = gid * WGM, gsz = (nM - fm) < WGM ? (nM - fm) : WGM;
        u.pm = fm + ((wgid % nig) % gsz); u.pn = (wgid % nig) / gsz; return true;
    }
};
template <class Epi, bool ALIGN_EPI = true>
__device__ __forceinline__ void gemm_phase(LAS unsigned char* lds, const Gemm g, const StaticOrder& S, const Epi& E) {
    const int tid = threadIdx.x, wid = __builtin_amdgcn_readfirstlane(tid >> 6), lane = tid & 63, wr = wid >> 2, wc = wid & 3, fr = lane & 15, fq = lane >> 4;
    const int K = g.K, nt = K / BK;
    unsigned voffA[2], voffB[2];
#pragma unroll
    for (int i = 0; i < 2; ++i) { int R, C; stage_rc(tid * 16 + i * 8192, R, C); const int Rb = (R & ~31) + perm32(R & 31);
        voffA[i] = (unsigned)(R * g.lda + C) * 2u; voffB[i] = (unsigned)(Rb * g.ldb + C) * 2u; }
    const size_t kstep = (size_t)(BK * 2);
    const size_t hstepA = (size_t)HALF * g.lda * 2, hstepB = (size_t)HALF * g.ldb * 2;
    const size_t tstepA = 2 * hstepA, tstepB = 2 * hstepB;
    const unsigned ldsw = (unsigned)wid * 1024u;
    const int aoff = lds_byte(wr * 64 + fr, fq * 8), boff = lds_byte(wc * 32 + fr, fq * 8);
#define PG8_SA(b, h) (((b) * 2 + (h)) * HTB)
#define PG8_SB(b, h) ((4 + (b) * 2 + (h)) * HTB)
#define PG8_STAGE(bufoff, gbase, voff) do { _Pragma("unroll") for (int _i = 0; _i < 2; ++_i) \
        __builtin_amdgcn_global_load_lds((const unsigned*)((const char*)(gbase) + (voff)[_i]), (LAS unsigned*)(lds + (bufoff) + ldsw + _i * 8192), 16, 0, 0); } while (0)
#define PG8_LDA(dst, b, h) do { _Pragma("unroll") for (int m = 0; m < 4; ++m) _Pragma("unroll") for (int k = 0; k < 2; ++k) dst[m][k] = *(const LAS bf16x8*)(lds + PG8_SA(b, h) + aoff + m * 2048 + k * 1024); } while (0)
#define PG8_LDB(dst, b, h) do { _Pragma("unroll") for (int n = 0; n < 2; ++n) _Pragma("unroll") for (int k = 0; k < 2; ++k) dst[n][k] = *(const LAS bf16x8*)(lds + PG8_SB(b, h) + boff + n * 2048 + k * 1024); } while (0)
#define PG8_MMA(ai, bj, At, Bt) do { __builtin_amdgcn_s_setprio(1); _Pragma("unroll") for (int m = 0; m < 4; ++m) _Pragma("unroll") for (int n = 0; n < 2; ++n) _Pragma("unroll") for (int k = 0; k < 2; ++k) \
        acc[ai][bj][m][n] = __builtin_amdgcn_mfma_f32_16x16x32_bf16(Bt[n][k], At[m][k], acc[ai][bj][m][n], 0, 0, 0); __builtin_amdgcn_s_setprio(0); } while (0)
#define PG8_WAIT_V(n) asm volatile("s_waitcnt vmcnt(" #n ")" ::: "memory")
#define PG8_WAIT_L(n) asm volatile("s_waitcnt lgkmcnt(" #n ")" ::: "memory")
#define PG8_BAR __builtin_amdgcn_s_barrier()
#define PG8_SCHED __builtin_amdgcn_sched_barrier(0)
    Unit cur, nxt; int ui = 0;
    if (!S.next(0, cur)) return;
    f32x4 acc[2][2][4][2];
#pragma unroll
    for (int a = 0; a < 2; ++a)
#pragma unroll
        for (int b = 0; b < 2; ++b)
#pragma unroll
            for (int m = 0; m < 4; ++m)
#pragma unroll
                for (int n = 0; n < 2; ++n) acc[a][b][m][n] = (f32x4){0.f, 0.f, 0.f, 0.f};
    bf16x8 At[4][2], B0[2][2], B1[2][2];
    const int ksm = (1 << g.ks_shift) - 1;
    const char* cA = (const char*)g.A + (size_t)cur.pm * tstepA + (size_t)cur.pn * g.a_pn_step + (size_t)(cur.pn >> g.ks_shift) * g.ks_bytes; const char* cB = (const char*)g.Bt + (size_t)(cur.pn & ksm) * tstepB + (size_t)(cur.pn >> g.ks_shift) * g.ks_bytes;
    PG8_STAGE(PG8_SB(0, 0), cB, voffB); PG8_STAGE(PG8_SB(0, 1), cB + hstepB, voffB); PG8_STAGE(PG8_SA(0, 0), cA, voffA); PG8_STAGE(PG8_SA(0, 1), cA + hstepA, voffA);
    if (wr == 1) PG8_BAR;
    PG8_WAIT_V(2); PG8_BAR;
    PG8_STAGE(PG8_SB(1, 0), cB + kstep, voffB); PG8_STAGE(PG8_SA(1, 0), cA + kstep, voffA); PG8_STAGE(PG8_SB(1, 1), cB + hstepB + kstep, voffB);
    PG8_WAIT_V(6); PG8_BAR;
    for (;;) {
        const bool has_next = S.next(ui + 1, nxt);
        const char* nA = has_next ? (const char*)g.A + (size_t)nxt.pm * tstepA + (size_t)nxt.pn * g.a_pn_step + (size_t)(nxt.pn >> g.ks_shift) * g.ks_bytes : cA; const char* nB = has_next ? (const char*)g.Bt + (size_t)(nxt.pn & ksm) * tstepB + (size_t)(nxt.pn >> g.ks_shift) * g.ks_bytes : cB;
#pragma unroll 1
        for (int t = 0; t < nt; t += 2) {
            const bool last = (t == nt - 2);
            const char* a1 = cA + (size_t)(t + 1) * kstep;
            const char* a2 = last ? nA : cA + (size_t)(t + 2) * kstep; const char* b2 = last ? nB : cB + (size_t)(t + 2) * kstep;
            const char* a3 = a2 + kstep; const char* b3 = b2 + kstep;
            PG8_LDB(B0, 0, 0); PG8_LDB(B1, 0, 1); PG8_SCHED; PG8_LDA(At, 0, 0); PG8_STAGE(PG8_SA(1, 1), a1 + hstepA, voffA);
            PG8_WAIT_V(8); PG8_WAIT_L(0); PG8_BAR; PG8_MMA(0, 0, At, B0); PG8_MMA(0, 1, At, B1); PG8_BAR; PG8_SCHED;
            PG8_LDA(At, 0, 1); PG8_STAGE(PG8_SB(0, 0), b2, voffB); PG8_STAGE(PG8_SB(0, 1), b2 + hstepB, voffB); PG8_STAGE(PG8_SA(0, 0), a2, voffA);
            PG8_WAIT_V(8); PG8_WAIT_L(0); PG8_BAR; PG8_MMA(1, 0, At, B0); PG8_MMA(1, 1, At, B1); PG8_BAR; PG8_SCHED;
            PG8_LDB(B0, 1, 0); PG8_LDB(B1, 1, 1); PG8_SCHED; PG8_LDA(At, 1, 0); PG8_STAGE(PG8_SA(0, 1), a2 + hstepA, voffA);
            PG8_WAIT_V(8); PG8_WAIT_L(0); PG8_BAR; PG8_MMA(0, 0, At, B0); PG8_MMA(0, 1, At, B1); PG8_BAR; PG8_SCHED;
            PG8_LDA(At, 1, 1); PG8_STAGE(PG8_SB(1, 0), b3, voffB); PG8_STAGE(PG8_SB(1, 1), b3 + hstepB, voffB); PG8_STAGE(PG8_SA(1, 0), a3, voffA);
            PG8_WAIT_V(8); PG8_WAIT_L(0); PG8_BAR; PG8_MMA(1, 0, At, B0); PG8_MMA(1, 1, At, B1); PG8_BAR; PG8_SCHED;
        }
        if (ALIGN_EPI) { if (wr == 0) PG8_BAR; }
        E(acc, cur, wr, wc, fr, fq);
        if (!has_next) break;
#pragma unroll
        for (int a = 0; a < 2; ++a)
#pragma unroll
            for (int b = 0; b < 2; ++b)
#pragma unroll
                for (int m = 0; m < 4; ++m)
#pragma unroll
                    for (int n = 0; n < 2; ++n) acc[a][b][m][n] = (f32x4){0.f, 0.f, 0.f, 0.f};
        cur = nxt; cA = nA; cB = nB; ++ui;
        if (ALIGN_EPI) { if (wr == 1) PG8_BAR; }
    }
    PG8_WAIT_V(0);
    if (!ALIGN_EPI) { if (wr == 0) PG8_BAR; }
    PG8_BAR;
#undef PG8_SA
#undef PG8_SB
#undef PG8_STAGE
#undef PG8_LDA
#undef PG8_LDB
#undef PG8_MMA
#undef PG8_WAIT_V
#undef PG8_WAIT_L
#undef PG8_BAR
#undef PG8_SCHED
}
}
typedef f32x4 AccT[2][2][4][2];

constexpr float QSCL = 0.08838834764831845f * 1.4426950408889634f;
struct EpiIn {
    bf16_t *QB, *QIB, *KP, *VP, *KS, *VS, *KIP, *KIS, *U; float *WI, *out;
    __device__ __forceinline__ void operator()(const AccT& acc, const pg8::Unit& u, int wr, int wc, int fr, int fq) const {
        const int pn = u.pn, sec = pn >> 2; const bool samp = u.pm >= 128;
        const int cl = (pn & 3) * 256 + wc * 32 + 8 * fq;
#pragma unroll
        for (int ai = 0; ai < 2; ++ai)
#pragma unroll
            for (int m = 0; m < 4; ++m) {
                const int r = u.pm * 256 + ai * 128 + wr * 64 + m * 16 + fr;
                const int rs = r - TP, bs = rs >> 6, ts = rs & 63;
#pragma unroll
                for (int bj = 0; bj < 2; ++bj) {
                    const int c = cl + bj * 128; const f32x4 v0 = acc[ai][bj][m][0], v1 = acc[ai][bj][m][1];
                    if (sec == 0) { *(u32x4*)(QB + (size_t)r * 1024 + c) = pack8(v0 * QSCL, v1 * QSCL); }
                    else if (sec == 3) { *(u32x4*)(QIB + (size_t)r * 1024 + c) = pack8(v0, v1); }
                    else if (sec == 1 || sec == 2) {
                        bf16_t* bb; float* fo;
                        if (!samp) { bb = (sec == 1 ? KP : VP) + (size_t)r * 1024 + c; fo = out + (sec == 1 ? O_KP : O_VP) + (size_t)r * 1024 + c; }
                        else { bb = (sec == 1 ? KS : VS) + (size_t)(bs * SK + PAST + ts) * 1024 + c; fo = out + (sec == 1 ? O_KS : O_VS) + (size_t)rs * 1024 + c; }
                        *(u32x4*)bb = pack8(v0, v1); __builtin_nontemporal_store(v0, (f32x4*)fo); __builtin_nontemporal_store(v1, (f32x4*)(fo + 4));
                    } else if (sec == 4) {
                        *(u32x4*)(U + (size_t)r * 1024 + c) = pack8(v0, v1);
                        if (!samp) { const int t = r & (SEQ - 1); if (t >= SEQ - 15) { float* po = out + O_PP + (size_t)((r >> 13) * 15 + (t - (SEQ - 15))) * 1024 + c; __builtin_nontemporal_store(v0, (f32x4*)po); __builtin_nontemporal_store(v1, (f32x4*)(po + 4)); } }
                        else if (ts >= DSEQ - 15) { float* po = out + O_PS + (size_t)(bs * 15 + (ts - (DSEQ - 15))) * 1024 + c; __builtin_nontemporal_store(v0, (f32x4*)po); __builtin_nontemporal_store(v1, (f32x4*)(po + 4)); }
                    } else {
                        if (c < 64) {
                            bf16_t* bb; float* fo;
                            if (!samp) { const int key = r & (SEQ - 1); bb = KIP + (size_t)(r >> 13) * SEQ * 64 + (size_t)(((key >> 5) * 8 + (c >> 3)) * 32 + (key & 31)) * 8; fo = out + O_KIP + (size_t)r * 64 + c; }
                            else { const int key = PAST + ts; bb = KIS + (size_t)bs * SK * 64 + (size_t)(((key >> 5) * 8 + (c >> 3)) * 32 + (key & 31)) * 8; fo = out + O_KIS + (size_t)rs * 64 + c; }
                            *(u32x4*)bb = pack8(v0, v1); __builtin_nontemporal_store(v0, (f32x4*)fo); __builtin_nontemporal_store(v1, (f32x4*)(fo + 4));
                        } else if (c < 80) {
                            float* wo = WI + (size_t)r * 16 + (c - 64); *(f32x4*)wo = v0 * 0.03125f; *(f32x4*)(wo + 4) = v1 * 0.03125f;
                        }
                    }
                }
            }
    }
};
struct EpiPool {
    bf16_t* MIX; const float* pscale;
    __device__ __forceinline__ void operator()(const AccT& acc, const pg8::Unit& u, int wr, int wc, int fr, int fq) const {
        const int c0 = u.pn * 256 + wc * 32 + 8 * fq;
#pragma unroll
        for (int bj = 0; bj < 2; ++bj) { const int c = c0 + bj * 128; const f32x4 s0 = *(const f32x4*)(pscale + c), s1 = *(const f32x4*)(pscale + c + 4);
#pragma unroll
            for (int ai = 0; ai < 2; ++ai)
#pragma unroll
                for (int m = 0; m < 4; ++m) { const int r = u.pm * 256 + ai * 128 + wr * 64 + m * 16 + fr;
                    *(u32x4*)(MIX + (size_t)r * 2048 + 1024 + c) = pack8(acc[ai][bj][m][0] * s0, acc[ai][bj][m][1] * s1); } }
    }
};
template <int WHICH>
struct EpiRes {
    const float *xp, *xs, *mods; float* Y;
    __device__ __forceinline__ void operator()(const AccT& acc, const pg8::Unit& u, int wr, int wc, int fr, int fq) const {
        const int c0 = u.pn * 256 + wc * 32 + 8 * fq;
#pragma unroll
        for (int ai = 0; ai < 2; ++ai) {
            const int rb = u.pm * 256 + ai * 128 + wr * 64; const float* gp = mods + (size_t)modrow(rb) * MODW + (WHICH == 0 ? 2 * D : 5 * D);
#pragma unroll
            for (int bj = 0; bj < 2; ++bj) { const int c = c0 + bj * 128; const f32x4 g0 = *(const f32x4*)(gp + c), g1 = *(const f32x4*)(gp + c + 4);
#pragma unroll
                for (int m = 0; m < 4; ++m) { const int r = rb + m * 16 + fr;
                    const float* src = WHICH == 0 ? (r < TP ? xp + (size_t)r * D : xs + (size_t)(r - TP) * D) : Y + (size_t)r * D;
                    const f32x4 a0 = *(const f32x4*)(src + c), a1 = *(const f32x4*)(src + c + 4);
                    float* dst = Y + (size_t)r * D + c; *(f32x4*)dst = a0 + g0 * acc[ai][bj][m][0]; *(f32x4*)(dst + 4) = a1 + g1 * acc[ai][bj][m][1]; } }
        }
    }
};
struct EpiPart {
    float* PART;
    __device__ __forceinline__ void operator()(const AccT& acc, const pg8::Unit& u, int wr, int wc, int fr, int fq) const {
        const int slice = u.pn >> 3, c0 = (u.pn & 7) * 256 + wc * 32 + 8 * fq;
#pragma unroll
        for (int ai = 0; ai < 2; ++ai)
#pragma unroll
            for (int m = 0; m < 4; ++m) { const int r = u.pm * 256 + ai * 128 + wr * 64 + m * 16 + fr;
#pragma unroll
                for (int bj = 0; bj < 2; ++bj) { float* dst = PART + ((size_t)slice * TS + r) * D + c0 + bj * 128; *(f32x4*)dst = acc[ai][bj][m][0]; *(f32x4*)(dst + 4) = acc[ai][bj][m][1]; } }
    }
};
struct EpiGU {
    bf16_t* ACT;
    __device__ __forceinline__ void operator()(const AccT& acc, const pg8::Unit& u, int wr, int wc, int fr, int fq) const {
        const int c = u.pn * 128 + wc * 32 + 8 * fq;
#pragma unroll
        for (int ai = 0; ai < 2; ++ai)
#pragma unroll
            for (int m = 0; m < 4; ++m) { const int r = u.pm * 256 + ai * 128 + wr * 64 + m * 16 + fr; f32x4 o[2];
#pragma unroll
                for (int n = 0; n < 2; ++n) { const f32x4 gt = acc[ai][0][m][n], up = acc[ai][1][m][n];
#pragma unroll
                    for (int e = 0; e < 4; ++e) o[n][e] = gt[e] * __builtin_amdgcn_rcpf(1.0f + __builtin_amdgcn_exp2f(-1.44269504f * gt[e])) * up[e]; }
                *(u32x4*)(ACT + (size_t)r * DFF + c) = pack8(o[0], o[1]); }
    }
};

__device__ __forceinline__ int inmap(int n) { return n < 4096 ? n : (n < 4160 ? 5120 + (n - 4096) : (n < 4176 ? 5184 + (n - 4160) : 4096 + (n - 4176))); }
template <int MAP>
__device__ __forceinline__ void tr_item(const float* W, int K, int N, bf16_t* WT, int row_off, LAS float* scr, int item, int lane) {
    const int nblk = (N + 31) / 32, kb = item / nblk, nb = item % nblk, k0 = 64 * kb, n0 = 32 * nb;
    const int nsrc = n0 + (lane & 31);
    float tv[32];
#pragma unroll
    for (int i = 0; i < 32; ++i) { const int kk = 2 * i + (lane >> 5); tv[i] = nsrc < N ? W[(size_t)(k0 + kk) * N + nsrc] : 0.f; }
#pragma unroll
    for (int i = 0; i < 32; ++i) { const int kk = 2 * i + (lane >> 5); scr[kk * 33 + (lane & 31)] = tv[i]; }
    asm volatile("s_waitcnt lgkmcnt(0)" ::: "memory");
    const int c = lane & 7;
#pragma unroll
    for (int j = 0; j < 4; ++j) { const int nl = (lane >> 3) + 8 * j, n = n0 + nl; const LAS float* s = scr + (8 * c) * 33 + nl;
        u32x4 o; o.x = cvt_pk_bf16(s[0 * 33], s[1 * 33]); o.y = cvt_pk_bf16(s[2 * 33], s[3 * 33]); o.z = cvt_pk_bf16(s[4 * 33], s[5 * 33]); o.w = cvt_pk_bf16(s[6 * 33], s[7 * 33]);
        if (n < N) { int dr; if (MAP == 0) dr = row_off + n; else if (MAP == 1) dr = inmap(n); else dr = 256 * (n >> 7) + (n & 127) + (MAP == 3 ? 128 : 0);
            *(u32x4*)(WT + (size_t)dr * K + k0 + 8 * c) = o; } }
    asm volatile("s_waitcnt lgkmcnt(0)" ::: "memory");
}
__device__ __forceinline__ void cvt_cache(const float* src, bf16_t* dst, int shift, size_t n4, size_t gtid, size_t nthr) {
    for (size_t i0 = gtid; i0 < n4; i0 += 8 * nthr) {
        f32x4 v[8];
#pragma unroll
        for (int u = 0; u < 8; ++u) { const size_t i = i0 + u * nthr; v[u] = (f32x4){0.f, 0.f, 0.f, 0.f}; if (i < n4) v[u] = *(const f32x4*)(src + i * 4); }
#pragma unroll
        for (int u = 0; u < 8; ++u) { const size_t i = i0 + u * nthr; if (i < n4) { const size_t e = i * 4, b = e >> shift, rem = e & (((size_t)1 << shift) - 1); *(u32x2*)(dst + b * ((size_t)SK << (shift - 11)) + rem) = pack4(v[u]); } }
    }
}
__device__ __forceinline__ void mods_task(const Params& P, LAS unsigned char* lds, int task) {
    const int tid = threadIdx.x, w = rfl(tid >> 6), lane = tid & 63;
    LAS float* T = (LAS float*)lds;
    for (int idx = tid; idx < 12 * D; idx += NTHREADS) { const int b = idx >> 11, k = idx & (D - 1); const float c = b < 4 ? P.cp[b * D + k] : P.cs[(b - 4) * D + k]; T[k * 12 + b] = c / (1.0f + __expf(-c)); }
    __syncthreads();
    f32x2 acc[12];
#pragma unroll
    for (int b = 0; b < 12; ++b) acc[b] = (f32x2){0.f, 0.f};
    const float* wp = P.wada + (size_t)(256 * w) * MODW + task * 128 + 2 * lane;
#pragma unroll 16
    for (int k = 0; k < 256; ++k) { const f32x2 wv = *(const f32x2*)(wp + (size_t)k * MODW); const LAS f32x4* tp = (const LAS f32x4*)(T + (256 * w + k) * 12); const f32x4 t0 = tp[0], t1 = tp[1], t2 = tp[2];
        acc[0] += wv * t0[0]; acc[1] += wv * t0[1]; acc[2] += wv * t0[2]; acc[3] += wv * t0[3]; acc[4] += wv * t1[0]; acc[5] += wv * t1[1]; acc[6] += wv * t1[2]; acc[7] += wv * t1[3];
        acc[8] += wv * t2[0]; acc[9] += wv * t2[1]; acc[10] += wv * t2[2]; acc[11] += wv * t2[3]; }
    __syncthreads();
    LAS float* Pp = (LAS float*)lds;
#pragma unroll
    for (int b = 0; b < 12; ++b) *(LAS f32x2*)(Pp + (w * 12 + b) * 128 + 2 * lane) = acc[b];
    __syncthreads();
    float* mods = (float*)(P.ws + WS_MODS);
    for (int o = tid; o < 12 * 128; o += NTHREADS) { const int b = o >> 7, cc = o & 127; float s = P.bada[task * 128 + cc];
#pragma unroll
        for (int ww = 0; ww < 8; ++ww) s += Pp[(ww * 12 + b) * 128 + cc];
        mods[(size_t)b * MODW + task * 128 + cc] = s; }
    __syncthreads();
}
__device__ __forceinline__ void phase0(const Params& P, LAS unsigned char* lds, int G, int c) {
    const int tid = threadIdx.x, w = rfl(tid >> 6), lane = tid & 63;
    if (c < 96) mods_task(P, lds, c);
    for (int t = c; t < 96; t += G) if (t != c || c >= 96) mods_task(P, lds, t);
    LAS float* scr = (LAS float*)(lds + w * 16384);
    const int gw = c * NWAVES + w, NGW = G * NWAVES;
    bf16_t* WIN = (bf16_t*)(P.ws + WS_WIN); bf16_t* WOUT = (bf16_t*)(P.ws + WS_WOUT); bf16_t* WGU = (bf16_t*)(P.ws + WS_WGU); bf16_t* WDN = (bf16_t*)(P.ws + WS_WDN); bf16_t* WPL = (bf16_t*)(P.ws + WS_WPOOL);
    constexpr int I_IN = (D / 64) * ((NIN + 31) / 32), I_OUT = (D / 64) * (D / 32), I_G = (D / 64) * (DFF / 32), I_DN = (DFF / 64) * (D / 32), I_PL = 4 * (256 / 64) * (256 / 32);
    constexpr int NITEMS = I_IN + I_OUT + 2 * I_G + I_DN + I_PL;
    for (int it = gw; it < NITEMS; it += NGW) {
        int r = it;
        if (r < I_IN) { tr_item<1>(P.win, D, NIN, WIN, 0, scr, r, lane); continue; } r -= I_IN;
        if (r < I_OUT) { tr_item<0>(P.wout, D, D, WOUT, 0, scr, r, lane); continue; } r -= I_OUT;
        if (r < I_G) { tr_item<2>(P.wgate, D, DFF, WGU, 0, scr, r, lane); continue; } r -= I_G;
        if (r < I_G) { tr_item<3>(P.wup, D, DFF, WGU, 0, scr, r, lane); continue; } r -= I_G;
        if (r < I_DN) { tr_item<0>(P.wdown, DFF, D, WDN, 0, scr, r, lane); continue; } r -= I_DN;
        { const int gi = r / 32, ri = r % 32; tr_item<0>(P.wpool + (size_t)gi * 65536, 256, 256, WPL, gi * 256, scr, ri, lane); }
    }
    const size_t gtid = (size_t)c * NTHREADS + tid, nthr = (size_t)G * NTHREADS;
    cvt_cache(P.ck, (bf16_t*)(P.ws + WS_KS), 21, (size_t)NBS * PAST * AW / 4, gtid, nthr);
    cvt_cache(P.cv, (bf16_t*)(P.ws + WS_VS), 21, (size_t)NBS * PAST * AW / 4, gtid, nthr);
    { bf16_t* KIS = (bf16_t*)(P.ws + WS_KIS);
      for (size_t i = gtid; i < (size_t)NBS * PAST * IDIM / 4; i += nthr) { const size_t e = i * 4, b = e >> 17; const int rem = (int)(e & 131071), key = rem >> 6, dim = rem & 63;
          const f32x4 v = *(const f32x4*)(P.cki + e); *(u32x2*)(KIS + b * ((size_t)SK * 64) + (size_t)(((key >> 5) * 8 + (dim >> 3)) * 32 + (key & 31)) * 8 + (dim & 7)) = pack4(v); } }
}

template <int MODE>
__device__ __forceinline__ void norm_phase(const Params& P, int G, int c) {
    const int tid = threadIdx.x, w = rfl(tid >> 6), lane = tid & 63;
    const int gw = c * NWAVES + w, NGW = G * NWAVES;
    const float* mods = (const float*)(P.ws + WS_MODS); bf16_t* H = (bf16_t*)(P.ws + WS_H);
    const float* gsrc = MODE == 0 ? P.g1 : (MODE == 1 ? P.g2 : P.gf);
    for (int task = gw; task < TS + TP / 16; task += NGW) {
        const int r0 = task < TS ? TP + task : (task - TS) * 16, nrows = task < TS ? 1 : 16, mb = modrow(r0);
        f32x4 gs[8], sh[8];
#pragma unroll
        for (int j = 0; j < 8; ++j) { const int col = 4 * lane + 256 * j; gs[j] = *(const f32x4*)(gsrc + col);
            if (MODE < 2) { const float* mp = mods + (size_t)mb * MODW + (MODE == 0 ? 0 : 3 * D); sh[j] = *(const f32x4*)(mp + col); gs[j] = gs[j] * (1.0f + *(const f32x4*)(mp + D + col)); } }
#define NRM_SRC(r_) (MODE == 0 ? ((r_) < TP ? P.xp + (size_t)(r_) * D : P.xs + (size_t)((r_) - TP) * D) : P.out + (size_t)(r_) * D)
#define NRM_FIN(v_, r_) do { float ss = 0.f; _Pragma("unroll") for (int j = 0; j < 8; ++j) ss += (v_[j][0] * v_[j][0] + v_[j][1] * v_[j][1]) + (v_[j][2] * v_[j][2] + v_[j][3] * v_[j][3]); \
            const float rstd = 1.0f / sqrtf(wave_sum(ss) * (1.0f / D) + 1e-6f); \
            _Pragma("unroll") for (int j = 0; j < 8; ++j) { const int col = 4 * lane + 256 * j; \
                if (MODE < 2) { const f32x4 o = v_[j] * rstd * gs[j] + sh[j]; *(u32x2*)(H + (size_t)(r_) * D + col) = pack4(o); } \
                else { __builtin_nontemporal_store(v_[j] * rstd * gs[j], (f32x4*)(P.out + (size_t)(r_) * D + col)); } } } while (0)
        if (nrows == 1) {
            const int r = r0; const float* src = NRM_SRC(r);
            f32x4 v[8];
#pragma unroll
            for (int j = 0; j < 8; ++j) v[j] = *(const f32x4*)(src + 4 * lane + 256 * j);
            if (MODE >= 1) {
                constexpr int NSL = MODE == 1 ? 8 : 11; const float* part = (const float*)(P.ws + (MODE == 1 ? WS_PART1 : WS_PART2)) + (size_t)(r - TP) * D;
                const float* gp = mods + (size_t)mb * MODW + (MODE == 1 ? 2 * D : 5 * D);
                const float* xsrc = MODE == 1 ? P.xs + (size_t)(r - TP) * D : src;
#pragma unroll
                for (int j = 0; j < 8; ++j) { const int col = 4 * lane + 256 * j; f32x4 a = (f32x4){0.f, 0.f, 0.f, 0.f};
                    f32x4 pv[NSL];
#pragma unroll
                    for (int sl = 0; sl < NSL; ++sl) pv[sl] = *(const f32x4*)(part + (size_t)sl * TS * D + col);
#pragma unroll
                    for (int sl = 0; sl < NSL; ++sl) a += pv[sl];
                    v[j] = *(const f32x4*)(xsrc + col) + *(const f32x4*)(gp + col) * a;
                    if (MODE == 1) *(f32x4*)(P.out + (size_t)r * D + col) = v[j]; }
            }
            NRM_FIN(v, r);
        } else {
            for (int rr = 0; rr < 16; rr += 2) {
                const int ra = r0 + rr, rb = ra + 1; const float* sa = NRM_SRC(ra); const float* sb = NRM_SRC(rb);
                f32x4 va[8], vb[8];
#pragma unroll
                for (int j = 0; j < 8; ++j) { va[j] = *(const f32x4*)(sa + 4 * lane + 256 * j); vb[j] = *(const f32x4*)(sb + 4 * lane + 256 * j); }
                NRM_FIN(va, ra); NRM_FIN(vb, rb);
            }
        }
#undef NRM_SRC
#undef NRM_FIN
    }
}

#define LDU(p_) ({ const u32x2 w_ = *(const u32x2*)(p_); (f32x4){__uint_as_float(w_.x << 16), __uint_as_float(w_.x & 0xffff0000u), __uint_as_float(w_.y << 16), __uint_as_float(w_.y & 0xffff0000u)}; })
template <int W>
__device__ __forceinline__ void z_task(const Params& P, const bf16_t* U, bf16_t* Z, int r0, int col, int lane) {
    constexpr int NR = 16 + W - 1;
    const bool samp = r0 >= TP; const int t0 = samp ? ((r0 - TP) & 63) : (r0 & (SEQ - 1)); const int seq0 = r0 - t0;
    const float* spre = samp ? P.sp + (size_t)((r0 - TP) >> 6) * 15 * 1024 : nullptr;
    f32x4 x[NR];
#pragma unroll
    for (int i = 0; i < NR; ++i) { const int tt = t0 - (W - 1) + i; x[i] = (f32x4){0.f, 0.f, 0.f, 0.f};
        if (tt >= 0) x[i] = LDU(U + (size_t)(seq0 + tt) * 1024 + col); else if (samp) x[i] = *(const f32x4*)(spre + (size_t)(15 + tt) * 1024 + col); }
    f32x4 sum = (f32x4){0.f, 0.f, 0.f, 0.f};
#pragma unroll
    for (int i = 0; i < W - 1; ++i) sum += x[i];
#pragma unroll
    for (int t = 0; t < 16; ++t) {
        sum += x[t + W - 1];
        const int tt = t0 + t, cnt = samp ? W : (tt + 1 < W ? tt + 1 : W);
        *(u32x2*)(Z + (size_t)(seq0 + tt) * 1024 + col) = pack4(sum * (1.0f / (float)cnt) - x[t + W - 1]);
        sum -= x[t];
    }
}
__device__ __forceinline__ void z_phase(const Params& P, int G, int c) {
    const int tid = threadIdx.x, w = rfl(tid >> 6), lane = tid & 63;
    const int gw = c * NWAVES + w, NGW = G * NWAVES;
    const bf16_t* U = (const bf16_t*)(P.ws + WS_U); bf16_t* Z = (bf16_t*)(P.ws + WS_Z);
    for (int task = gw; task < (MT / 16) * 4; task += NGW) {
        const int grp = task & 3, r0 = (task >> 2) * 16, col = grp * 256 + 4 * lane;
        if (grp == 0) z_task<2>(P, U, Z, r0, col, lane); else if (grp == 1) z_task<4>(P, U, Z, r0, col, lane); else if (grp == 2) z_task<8>(P, U, Z, r0, col, lane); else z_task<16>(P, U, Z, r0, col, lane);
    }
}

__device__ __forceinline__ unsigned fkey(float f) { const unsigned u = __float_as_uint(f); return u ^ ((u >> 31) ? 0xFFFFFFFFu : 0x80000000u); }
#ifndef IDX_SELFCHECK
#define IDX_SELFCHECK 0
#endif
#ifndef IDX_FORCE_SLOW
#define IDX_FORCE_SLOW 0
#endif
constexpr int LCAP = 384;
constexpr int NIDX_UNITS = 1024 + 16, HQW = 1088;
__device__ __forceinline__ void hscan(const LAS unsigned* h, unsigned krem, int lane, int& digit, unsigned& above, unsigned& cnt) {
    unsigned wd[16]; unsigned cl = 0u;
#pragma unroll
    for (int i = 0; i < 16; ++i) { wd[i] = h[17 * lane + i]; cl += (wd[i] & 0xffffu) + (wd[i] >> 16); }
    unsigned incl = cl;
#pragma unroll
    for (int off = 1; off < 64; off <<= 1) { const unsigned t = __shfl_down(incl, off); if (lane + off < 64) incl += t; }
    unsigned cum = incl - cl; const bool mine = (cum < krem) && (krem <= incl);
    int dg = -1; unsigned ab = 0u, cn = 0u;
#pragma unroll
    for (int i = 15; i >= 0; --i) {
        const unsigned hi = wd[i] >> 16, lo = wd[i] & 0xffffu;
        if (dg < 0 && cum + hi >= krem) { dg = 32 * lane + 2 * i + 1; ab = cum; cn = hi; } cum += hi;
        if (dg < 0 && cum + lo >= krem) { dg = 32 * lane + 2 * i; ab = cum; cn = lo; } cum += lo;
    }
    const unsigned long long bal = __ballot(mine); const int srcl = bal ? (__ffsll((long long)bal) - 1) : 0;
    digit = __shfl(dg, srcl); above = __shfl(ab, srcl); cnt = __shfl(cn, srcl);
}
__device__ __forceinline__ void idx_phase(const Params& P, LAS unsigned char* lds, int G, int c) {
    const int tid = threadIdx.x, w = rfl(tid >> 6), lane = tid & 63, r = lane & 31, hh = lane >> 5;
    const bf16_t* QIB = (const bf16_t*)(P.ws + WS_QIB); const float* WI = (const float*)(P.ws + WS_WI);
    float* scratch = P.out + (size_t)c * (32 * 8192) + (size_t)(4 * w) * 8192;
    LAS unsigned* hist = (LAS unsigned*)(lds + w * (4 * HQW * 4));
    for (int it = 0; it * G < NIDX_UNITS; ++it) {
        const int L = snake(it, G, c); if (L >= NIDX_UNITS) continue;
        int row0, n, nend, mpitch; const bf16_t* ki; unsigned* mk;
        const bool is_p = L < 760 || L >= 776; const int Lp = L < 760 ? L : L - 16;
        if (is_p) { const int hc = 255 - (Lp >> 2), b = Lp & 3, t0 = 32 * hc; row0 = b * SEQ + t0; n = 64 * ((hc >> 1) + 1); nend = 256 * ((t0 >> 8) + 1); mpitch = 256;
            ki = (const bf16_t*)(P.ws + WS_KIP) + (size_t)b * SEQ * 64; mk = (unsigned*)(P.ws + WS_MASKP) + (size_t)row0 * 256; }
        else { const int s = L - 760, bs = s >> 1, t0 = 32 * (s & 1); row0 = TP + bs * 64 + t0; n = SK; nend = SK; mpitch = 66;
            ki = (const bf16_t*)(P.ws + WS_KIS) + (size_t)bs * SK * 64; mk = (unsigned*)(P.ws + WS_MASKS) + (size_t)(bs * 64 + t0) * 66; }
        mk += (size_t)(4 * w) * mpitch;
        bf16x8 af[2][4]; f32x4 wv[2][4];
#pragma unroll
        for (int p = 0; p < 2; ++p) { const int t = 4 * w + 2 * p + ((r >> 2) & 1), head = (r & 3) + 4 * (r >> 3);
            const bf16_t* qrow = QIB + (size_t)(row0 + t) * 1024 + head * 64 + 8 * hh;
#pragma unroll
            for (int ks = 0; ks < 4; ++ks) af[p][ks] = *(const bf16x8*)(qrow + 16 * ks);
            const float* wrow = WI + (size_t)(row0 + 4 * w + 2 * p + hh) * 16;
#pragma unroll
            for (int q = 0; q < 4; ++q) wv[p][q] = *(const f32x4*)(wrow + 4 * q); }
        const bool all = n <= 256;
        for (int rep_s = 0; rep_s < IDX_REP_SCORE; ++rep_s) {
        for (int i = lane; i < 4 * HQW; i += 64) hist[i] = 0u;
        const bf16_t* kp = ki + (size_t)lane * 8;
        bf16x8 b0[4], b1[4], c0[4], c1[4];
        const int nsub = n >> 5, nsub4 = (nsub + 3) & ~3, lim = nsub4 - 1;
#define IDX_LOAD(bb_, sub_) do { _Pragma("unroll") for (int ks = 0; ks < 4; ++ks) bb_[ks] = *(const bf16x8*)(kp + (size_t)(sub_) * 2048 + 512 * ks); } while (0)
        IDX_LOAD(b0, 0); IDX_LOAD(b1, 1);
#define IDX_TAIL(sub_, p_, acc_) do { float s0_ = 0.f, s1_ = 0.f; _Pragma("unroll") for (int i = 0; i < 16; i += 2) { s0_ += wv[p_][i >> 2][i & 3] * __builtin_amdgcn_fmed3f(acc_[i], 0.f, 3.0e38f); s1_ += wv[p_][(i + 1) >> 2][(i + 1) & 3] * __builtin_amdgcn_fmed3f(acc_[i + 1], 0.f, 3.0e38f); } \
            const float sc_ = (s0_ + s1_) + 0.0f;     \
            scratch[(size_t)(2 * (p_) + hh) * 8192 + 32 * (sub_) + r] = sc_; \
            if (!all && (sub_) < nsub) { const unsigned bn_ = fkey(sc_) >> 21; __hip_atomic_fetch_add(hist + (2 * (p_) + hh) * HQW + (bn_ >> 1) + (bn_ >> 5), 1u << (16 * (bn_ & 1)), __ATOMIC_RELAXED, __HIP_MEMORY_SCOPE_WORKGROUP); } } while (0)
#define IDX_MMA(acc_, p_, bb_) do { _Pragma("unroll") for (int i = 0; i < 16; ++i) acc_[i] = 0.f; __builtin_amdgcn_s_setprio(1); _Pragma("unroll") for (int ks = 0; ks < 4; ++ks) acc_ = __builtin_amdgcn_mfma_f32_32x32x16_bf16(af[p_][ks], bb_[ks], acc_, 0, 0, 0); __builtin_amdgcn_s_setprio(0); } while (0)
        for (int sub = 0; sub < nsub4; sub += 4) {
            f32x16 accA;
            IDX_MMA(accA, 0, b0); asm volatile("" : "+v"(accA) : : "memory"); IDX_LOAD(c0, min(sub + 2, lim)); IDX_LOAD(c1, min(sub + 3, lim)); asm volatile("" : "+v"(accA) : : "memory");
            IDX_TAIL(sub, 0, accA);
            IDX_MMA(accA, 1, b0); IDX_TAIL(sub, 1, accA);
            IDX_MMA(accA, 0, b1); IDX_TAIL(sub + 1, 0, accA);
            IDX_MMA(accA, 1, b1); IDX_TAIL(sub + 1, 1, accA);
            IDX_MMA(accA, 0, c0);
            asm volatile("" : "+v"(accA) : : "memory"); IDX_LOAD(b0, min(sub + 4, lim)); IDX_LOAD(b1, min(sub + 5, lim)); asm volatile("" : "+v"(accA) : : "memory");
            IDX_TAIL(sub + 2, 0, accA);
            IDX_MMA(accA, 1, c0); IDX_TAIL(sub + 2, 1, accA);
            IDX_MMA(accA, 0, c1); IDX_TAIL(sub + 3, 0, accA);
            IDX_MMA(accA, 1, c1); IDX_TAIL(sub + 3, 1, accA);
        }
#undef IDX_MMA
#undef IDX_TAIL
#undef IDX_LOAD
        }
        asm volatile("s_waitcnt vmcnt(0) lgkmcnt(0)" ::: "memory");
#define SC_LOAD(vv_, jb_) do { _Pragma("unroll") for (int q = 0; q < 4; ++q) _Pragma("unroll") for (int k = 0; k < 2; ++k) { const int idx_ = (jb_) + 256 * k + 4 * lane; vv_[q][k] = *(const f32x4*)(scratch + (size_t)q * 8192 + (idx_ < n ? idx_ : 0)); } } while (0)
#define KEYINV(u_) (((u_) & 0x80000000u) ? ((u_) ^ 0x80000000u) : ~(u_))
        unsigned T[4] = {0u, 0u, 0u, 0u}; unsigned pm[4]; int kr[4]; bool dn[4]; unsigned cn1[4];
        bool fast = false;
        if (!all) {
#pragma unroll
            for (int q = 0; q < 4; ++q) { int dg; unsigned ab, cn; hscan(hist + q * HQW, 256u, lane, dg, ab, cn); T[q] = (unsigned)dg << 21; pm[q] = 0xFFE00000u; kr[q] = 256 - (int)ab; dn[q] = ((int)cn == kr[q]); cn1[q] = cn; }
            fast = !IDX_FORCE_SLOW && cn1[0] <= LCAP && cn1[1] <= LCAP && cn1[2] <= LCAP && cn1[3] <= LCAP;
        }
        if (fast) {
            LAS unsigned* lst = hist; LAS unsigned* h2 = hist + 4 * LCAP * 2;
            float loF[4], hiF[4]; unsigned base[4] = {0u, 0u, 0u, 0u};
#pragma unroll
            for (int q = 0; q < 4; ++q) { const unsigned hk = T[q] + (1u << 21); loF[q] = __uint_as_float(KEYINV(T[q])); hiF[q] = hk == 0u ? __builtin_inff() : __uint_as_float(KEYINV(hk)); if (dn[q]) hiF[q] = loF[q]; }
#define CB_PROC(vv_, jb_) do { _Pragma("unroll") for (int q = 0; q < 4; ++q) _Pragma("unroll") for (int k = 0; k < 2; ++k) { const int kb_ = (jb_) + 256 * k, idx_ = kb_ + 4 * lane; unsigned nib = 0u; const bool ok_ = idx_ < n; \
                    _Pragma("unroll") for (int e = 0; e < 4; ++e) { const float x_ = vv_[q][k][e]; const bool s_ = ok_ && x_ >= hiF[q]; const bool i_ = ok_ && !s_ && x_ >= loF[q]; nib |= (s_ ? 1u : 0u) << e; \
                        const unsigned long long bal_ = __ballot(i_); if (bal_) { const unsigned pos_ = base[q] + __builtin_amdgcn_mbcnt_hi((unsigned)(bal_ >> 32), __builtin_amdgcn_mbcnt_lo((unsigned)bal_, 0u)); \
                            if (i_) { lst[(q * LCAP + pos_) * 2] = __float_as_uint(x_); lst[(q * LCAP + pos_) * 2 + 1] = (unsigned)(idx_ + e); } base[q] += (unsigned)__popcll(bal_); } } \
                    unsigned wd = nib << (4 * (lane & 7)); wd |= __shfl_xor(wd, 1); wd |= __shfl_xor(wd, 2); wd |= __shfl_xor(wd, 4); \
                    const int widx = (kb_ >> 5) + (lane >> 3); if ((lane & 7) == 0 && widx < mpitch && kb_ < nend) mk[(size_t)q * mpitch + widx] = wd; } } while (0)
            { const int nbm = ((nend + 511) >> 9) + 1 & ~1;
              f32x4 va[4][2], vb[4][2];
              SC_LOAD(va, 0);
#if IDX_SELFCHECK
              for (int bt = 0; bt < nbm; ++bt) { SC_LOAD(vb, bt * 512); CB_PROC(vb, bt * 512); } (void)va;
#else
              for (int bt = 0; bt < nbm; bt += 2) { SC_LOAD(vb, (bt + 1) * 512); CB_PROC(va, bt * 512); SC_LOAD(va, (bt + 2) * 512); CB_PROC(vb, (bt + 1) * 512); }
#endif
            }
#undef CB_PROC
            asm volatile("s_waitcnt vmcnt(0) lgkmcnt(0)" ::: "memory");
#pragma unroll
            for (int q = 0; q < 4; ++q) if (!dn[q]) {
                const int m = (int)base[q]; unsigned Tq = T[q], pmq = pm[q]; int krq = kr[q];
                for (int pass = 1; pass < 3; ++pass) {
                    const int shift = pass == 1 ? 10 : 0; const unsigned dm = pass == 1 ? 2047u : 1023u;
                    for (int i = lane; i < HQW; i += 64) h2[i] = 0u;
                    for (int i = lane; i < m; i += 64) { const unsigned u = fkey(__uint_as_float(lst[(q * LCAP + i) * 2])); if ((u & pmq) == Tq) { const unsigned bn = (u >> shift) & dm; __hip_atomic_fetch_add(h2 + (bn >> 1) + (bn >> 5), 1u << (16 * (bn & 1)), __ATOMIC_RELAXED, __HIP_MEMORY_SCOPE_WORKGROUP); } }
                    int dg; unsigned ab, cn; hscan(h2, (unsigned)krq, lane, dg, ab, cn); Tq |= (unsigned)dg << shift; pmq |= dm << shift; krq -= (int)ab;
                    if ((int)cn == krq) break;
                }
                for (int i = lane; i < m; i += 64) { const unsigned u = fkey(__uint_as_float(lst[(q * LCAP + i) * 2])); if (u >= Tq) { const unsigned ix = lst[(q * LCAP + i) * 2 + 1]; __hip_atomic_fetch_or(mk + (size_t)q * mpitch + (ix >> 5), 1u << (ix & 31u), __ATOMIC_RELAXED, __HIP_MEMORY_SCOPE_AGENT); } }
            }
        } else {
            if (!all) {
                for (int pass = 1; pass < 3; ++pass) {
                    if (dn[0] && dn[1] && dn[2] && dn[3]) break;
                    const int shift = pass == 1 ? 10 : 0; const unsigned dm = pass == 1 ? 2047u : 1023u;
                    for (int i = lane; i < 4 * HQW; i += 64) hist[i] = 0u;
#define P2_PROC(vv_, jb_) do { _Pragma("unroll") for (int q = 0; q < 4; ++q) _Pragma("unroll") for (int k = 0; k < 2; ++k) { const int idx_ = (jb_) + 256 * k + 4 * lane; \
                    if (!dn[q] && idx_ < n) { _Pragma("unroll") for (int e = 0; e < 4; ++e) { const unsigned u = fkey(vv_[q][k][e]); \
                        if ((u & pm[q]) == T[q]) { const unsigned bn = (u >> shift) & dm; __hip_atomic_fetch_add(hist + q * HQW + (bn >> 1) + (bn >> 5), 1u << (16 * (bn & 1)), __ATOMIC_RELAXED, __HIP_MEMORY_SCOPE_WORKGROUP); } } } } } while (0)
                    { const int nb2 = ((n + 511) >> 9) + 1 & ~1;
                      f32x4 va[4][2], vb[4][2];
                      SC_LOAD(va, 0);
                      for (int bt = 0; bt < nb2; bt += 2) { SC_LOAD(vb, (bt + 1) * 512); P2_PROC(va, bt * 512); SC_LOAD(va, (bt + 2) * 512); P2_PROC(vb, (bt + 1) * 512); } }
#undef P2_PROC
#pragma unroll
                    for (int q = 0; q < 4; ++q) if (!dn[q]) { int dg; unsigned ab, cn; hscan(hist + q * HQW, (unsigned)kr[q], lane, dg, ab, cn); T[q] |= (unsigned)dg << shift; pm[q] |= dm << shift; kr[q] -= (int)ab; dn[q] = ((int)cn == kr[q]); }
                }
            }
            float Tf[4];
#pragma unroll
            for (int q = 0; q < 4; ++q) Tf[q] = all ? -__builtin_inff() : __uint_as_float(KEYINV(T[q]));
#define MK_PROC(vv_, jb_) do { _Pragma("unroll") for (int q = 0; q < 4; ++q) _Pragma("unroll") for (int k = 0; k < 2; ++k) { const int kb_ = (jb_) + 256 * k, idx_ = kb_ + 4 * lane; unsigned nib = 0u; \
                    _Pragma("unroll") for (int e = 0; e < 4; ++e) nib |= (vv_[q][k][e] >= Tf[q] ? 1u : 0u) << e; \
                    unsigned wd = (idx_ < n ? nib : 0u) << (4 * (lane & 7)); wd |= __shfl_xor(wd, 1); wd |= __shfl_xor(wd, 2); wd |= __shfl_xor(wd, 4); \
                    const int widx = (kb_ >> 5) + (lane >> 3); if ((lane & 7) == 0 && widx < mpitch && kb_ < nend) mk[(size_t)q * mpitch + widx] = wd; } } while (0)
            for (int rep_m = 0; rep_m < IDX_REP_MASK; ++rep_m) {
                const int nbm = ((nend + 511) >> 9) + 1 & ~1;
                f32x4 va[4][2], vb[4][2];
                SC_LOAD(va, 0);
                for (int bt = 0; bt < nbm; bt += 2) { SC_LOAD(vb, (bt + 1) * 512); MK_PROC(va, bt * 512); SC_LOAD(va, (bt + 2) * 512); MK_PROC(vb, (bt + 1) * 512); }
            }
#undef MK_PROC
        }
#undef SC_LOAD
#undef KEYINV
#if IDX_SELFCHECK
        asm volatile("s_waitcnt vmcnt(0) lgkmcnt(0)" ::: "memory");
#pragma unroll 1
        for (int q = 0; q < 4; ++q) {
            int cnt = 0; float smin = __builtin_inff(), umax = -__builtin_inff();
            for (int j = lane; j < nend; j += 64) {
                const unsigned wdv = __hip_atomic_load(mk + (size_t)q * mpitch + (j >> 5), __ATOMIC_RELAXED, __HIP_MEMORY_SCOPE_AGENT); const bool sel = (wdv >> (j & 31)) & 1u;
                if (j < n) { const float x = __hip_atomic_load(scratch + (size_t)q * 8192 + j, __ATOMIC_RELAXED, __HIP_MEMORY_SCOPE_AGENT); if (sel) { ++cnt; smin = fminf(smin, x); } else umax = fmaxf(umax, x); }
                else if (sel) ++cnt;
            }
#pragma unroll
            for (int o = 1; o < 64; o <<= 1) { cnt += __shfl_xor(cnt, o); smin = fminf(smin, __shfl_xor(smin, o)); umax = fmaxf(umax, __shfl_xor(umax, o)); }
            const int want = n < 256 ? n : 256;
            if (lane == 0 && (cnt != want || !(smin >= umax))) __hip_atomic_fetch_add((unsigned*)P.ws + 4000, 1u, __ATOMIC_RELAXED, __HIP_MEMORY_SCOPE_AGENT);
        }
#endif
    }
}

constexpr int NATT_UNITS = 1024 + 64;
__device__ __forceinline__ void attn_phase(const Params& P, LAS unsigned char* lds, int G, int c) {
    const int tid = threadIdx.x, w = rfl(tid >> 6), lane = tid & 63, l15 = lane & 15, g = lane >> 4;
    const bf16_t* QB = (const bf16_t*)(P.ws + WS_QB); bf16_t* MIX = (bf16_t*)(P.ws + WS_MIX);
    constexpr unsigned KOFF = 0u, VOFF = 65536u;
    const int srow = (w * 64 + lane) >> 4, spc = lane & 15;
    const int kch = spc ^ (srow & 15), vch = spc ^ (2 * (srow & 7));
    for (int it = 0; it * G < NATT_UNITS; ++it) {
        const int L = snake(it, G, c); if (L >= NATT_UNITS) continue;
        int row0, nq, ntiles, mpitch, h; const bf16_t *Kb, *Vb; const unsigned* mk;
        const bool is_p = L < 768 || L >= 832; const int Lp = L < 768 ? L : L - 64;
        if (is_p) { const int qb = 31 - (Lp >> 5), bh = Lp & 31, b = bh >> 3; h = bh & 7; row0 = b * SEQ + 256 * qb; nq = 256; ntiles = 4 * (qb + 1); mpitch = 256;
            Kb = (const bf16_t*)(P.ws + WS_KP) + (size_t)b * SEQ * 1024; Vb = (const bf16_t*)(P.ws + WS_VP) + (size_t)b * SEQ * 1024; mk = (const unsigned*)(P.ws + WS_MASKP) + (size_t)row0 * 256; }
        else { const int s = L - 768, bs = s >> 3; h = s & 7; row0 = TP + bs * 64; nq = 64; ntiles = SK / 64; mpitch = 66;
            Kb = (const bf16_t*)(P.ws + WS_KS) + (size_t)bs * SK * 1024; Vb = (const bf16_t*)(P.ws + WS_VS) + (size_t)bs * SK * 1024; mk = (const unsigned*)(P.ws + WS_MASKS) + (size_t)(bs * 64) * 66; }
        const bool active = 32 * w < nq;
        bf16x8 qf[2][4]; f32x4 O[2][9]; float mrun[2]; const unsigned* mrow[2];
        const bf16x8 ones = (bf16x8){0x3F80, 0x3F80, 0x3F80, 0x3F80, 0x3F80, 0x3F80, 0x3F80, 0x3F80};
#pragma unroll
        for (int qs = 0; qs < 2; ++qs) { mrun[qs] = -1e20f; const int ql = active ? 32 * w + 16 * qs + l15 : 0; mrow[qs] = mk + (size_t)ql * mpitch;
#pragma unroll
            for (int ks = 0; ks < 4; ++ks) qf[qs][ks] = *(const bf16x8*)(QB + (size_t)(row0 + ql) * 1024 + h * 128 + 32 * ks + 8 * g);
#pragma unroll
            for (int cc = 0; cc < 9; ++cc) O[qs][cc] = (f32x4){0.f, 0.f, 0.f, 0.f}; }
        const bf16_t* kg = Kb + (size_t)srow * 1024 + h * 128 + kch * 8; const bf16_t* vg = Vb + (size_t)srow * 1024 + h * 128 + vch * 8;
#define ATT_STAGE(kt_, buf_) do { const size_t go_ = (size_t)(64 * (kt_)) * 1024; LAS unsigned char* kd_ = lds + KOFF + (buf_) * 32768u + (unsigned)((kt_) & 1) * 16384u + (unsigned)w * 1024u; LAS unsigned char* vd_ = lds + VOFF + (buf_) * 32768u + (unsigned)((kt_) & 1) * 16384u + (unsigned)w * 1024u; \
            __builtin_amdgcn_global_load_lds((const unsigned*)(kg + go_), (LAS unsigned*)kd_, 16, 0, 0); __builtin_amdgcn_global_load_lds((const unsigned*)(kg + go_ + 32 * 1024), (LAS unsigned*)(kd_ + 8192), 16, 0, 0); \
            __builtin_amdgcn_global_load_lds((const unsigned*)(vg + go_), (LAS unsigned*)vd_, 16, 0, 0); __builtin_amdgcn_global_load_lds((const unsigned*)(vg + go_ + 32 * 1024), (LAS unsigned*)(vd_ + 8192), 16, 0, 0); } while (0)
        ATT_STAGE(0, 0u); if (ntiles > 1) ATT_STAGE(1, 0u);
        asm volatile("s_waitcnt vmcnt(0)" ::: "memory"); __syncthreads();
        for (int kt = 0; kt < ntiles; ++kt) {
            const unsigned sbuf = (unsigned)((kt >> 1) & 1);
            const unsigned kb = KOFF + sbuf * 32768u + (unsigned)(kt & 1) * 16384u, vb = VOFF + sbuf * 32768u + (unsigned)(kt & 1) * 16384u;
            if ((kt & 1) == 0) { if (kt + 2 < ntiles) ATT_STAGE(kt + 2, sbuf ^ 1u); if (kt + 3 < ntiles) ATT_STAGE(kt + 3, sbuf ^ 1u); }
            if (active) {
                f32x4 S[2][4];
#pragma unroll
                for (int qs = 0; qs < 2; ++qs)
#pragma unroll
                    for (int sub = 0; sub < 4; ++sub) S[qs][sub] = (f32x4){0.f, 0.f, 0.f, 0.f};
                __builtin_amdgcn_s_setprio(1);
#pragma unroll
                for (int sub = 0; sub < 4; ++sub)
#pragma unroll
                    for (int ks = 0; ks < 4; ++ks) { const bf16x8 kf = *(const LAS bf16x8*)(lds + kb + (16 * sub + l15) * 256 + (((4 * ks + g) ^ l15) * 16));
#pragma unroll
                        for (int qs = 0; qs < 2; ++qs) S[qs][sub] = __builtin_amdgcn_mfma_f32_16x16x32_bf16(kf, qf[qs][ks], S[qs][sub], 0, 0, 0); }
                __builtin_amdgcn_s_setprio(0);
                bf16x8 pf[2][2];
#pragma unroll
                for (int qs = 0; qs < 2; ++qs) {
                    const u32x2 mw = *(const u32x2*)(mrow[qs] + 2 * kt);
                    const unsigned m0 = mw.x >> (4 * g), m1 = mw.y >> (4 * g);
                    float sv[4][4]; float mx = -1e30f;
#pragma unroll
                    for (int sub = 0; sub < 4; ++sub)
#pragma unroll
                        for (int i = 0; i < 4; ++i) { const unsigned word = (sub >> 1) ? m1 : m0; const unsigned t = (unsigned)__builtin_amdgcn_sbfe((int)word, 16 * (sub & 1) + i, 1);
                            sv[sub][i] = __uint_as_float((__float_as_uint(S[qs][sub][i]) & t) | (0xF149F2CAu & ~t));     mx = fmaxf(mx, sv[sub][i]); }
                    mx = fmaxf(mx, __shfl_xor(mx, 16)); mx = fmaxf(mx, __shfl_xor(mx, 32));
                    const float mnew = fmaxf(mrun[qs], mx);
                    if (__any(mnew != mrun[qs])) {
                        const float alpha = __builtin_amdgcn_exp2f(mrun[qs] - mnew);
#pragma unroll
                        for (int cc = 0; cc < 9; ++cc) O[qs][cc] = O[qs][cc] * alpha;
                    }
                    mrun[qs] = mnew;
                    f32x4 pp[4];
#pragma unroll
                    for (int sub = 0; sub < 4; ++sub)
#pragma unroll
                        for (int i = 0; i < 4; ++i) pp[sub][i] = __builtin_amdgcn_exp2f(sv[sub][i] - mnew);
#pragma unroll
                    for (int k2 = 0; k2 < 2; ++k2) { const u32x4 pw = pack8(pp[2 * k2], pp[2 * k2 + 1]); pf[qs][k2] = __builtin_bit_cast(bf16x8, pw); }
                }
                const int vxh = 4 * (g & 1) + (l15 >> 2);
                __builtin_amdgcn_s_setprio(1);
                const LAS unsigned char* vp = lds + vb + (4 * g + (l15 >> 2)) * 256 + ((lane >> 1) & 1) * 16 + (lane & 1) * 8;
#pragma unroll
                for (int cc = 0; cc < 8; ++cc)
#pragma unroll
                    for (int k2 = 0; k2 < 2; ++k2) {
                        const s16x4 va = __builtin_amdgcn_ds_read_tr16_b64_v4i16((LAS s16x4*)(vp + (32 * k2) * 256 + ((cc ^ vxh) * 32)));
                        const s16x4 vbv = __builtin_amdgcn_ds_read_tr16_b64_v4i16((LAS s16x4*)(vp + (32 * k2 + 16) * 256 + ((cc ^ vxh) * 32)));
                        const bf16x8 vf = (bf16x8){va[0], va[1], va[2], va[3], vbv[0], vbv[1], vbv[2], vbv[3]};
#pragma unroll
                        for (int qs = 0; qs < 2; ++qs) O[qs][cc] = __builtin_amdgcn_mfma_f32_16x16x32_bf16(vf, pf[qs][k2], O[qs][cc], 0, 0, 0);
                    }
#pragma unroll
                for (int k2 = 0; k2 < 2; ++k2)
#pragma unroll
                    for (int qs = 0; qs < 2; ++qs) O[qs][8] = __builtin_amdgcn_mfma_f32_16x16x32_bf16(ones, pf[qs][k2], O[qs][8], 0, 0, 0);
                __builtin_amdgcn_s_setprio(0);
            }
            if ((kt & 1) || kt + 1 == ntiles) { asm volatile("s_waitcnt vmcnt(0)" ::: "memory"); __syncthreads(); }
        }
#undef ATT_STAGE
        if (active) {
#pragma unroll
            for (int qs = 0; qs < 2; ++qs) { const float inv = 1.0f / O[qs][8][0];
                bf16_t* orow = MIX + (size_t)(row0 + 32 * w + 16 * qs + l15) * 2048 + h * 128 + 4 * g;
#pragma unroll
                for (int cc = 0; cc < 8; ++cc) *(u32x2*)(orow + 16 * cc) = pack4(O[qs][cc] * inv); }
        }
    }
}


#define XB_TMO      128
#define XB_XCNT(j)  (256  + 64 * (j))
#define XB_XSUB(j)  (1280 + 64 * (j))
#define XB_XGEN(j)  (2304 + 64 * (j))
#define XB_TOP      3328
#define XB_TOPGEN   3392
#define XCD_BAR_WORDS 3456
#define XB_SPIN_CAP (1u << 20)
__device__ __forceinline__ unsigned xb_ld(unsigned* p)              { return __hip_atomic_load(p, __ATOMIC_RELAXED, __HIP_MEMORY_SCOPE_AGENT); }
__device__ __forceinline__ unsigned xb_add(unsigned* p, unsigned v) { return __hip_atomic_fetch_add(p, v, __ATOMIC_RELAXED, __HIP_MEMORY_SCOPE_AGENT); }
__device__ __forceinline__ unsigned xb_xcc_id() { return (unsigned)__builtin_amdgcn_s_getreg((3 << 11) | 20) & 0xFu; }
#define XB_SPIN(cond, bar) do { unsigned _sp = 0; while (cond) { __builtin_amdgcn_s_sleep(1); \
    if ((++_sp & 255u) == 0u) { if (xb_ld(&(bar)[XB_TMO])) break; if (_sp > XB_SPIN_CAP) { atomicAdd(&(bar)[XB_TMO], 1u); break; } } } } while (0)
struct XcdBarrier { unsigned* bar; unsigned x; volatile LAS unsigned* st; };
__device__ __forceinline__ XcdBarrier xcd_barrier_post(unsigned* bar, volatile LAS unsigned* st) {
    XcdBarrier b; b.bar = bar; b.x = xb_xcc_id(); b.st = st;
    if (threadIdx.x == 0) (void)xb_add(&bar[XB_XCNT(b.x)], 1u);
    return b;
}
__device__ __forceinline__ void xcd_barrier_complete(unsigned* bar, unsigned x, unsigned& nloc, unsigned& nx) {
    const unsigned G = gridDim.x * gridDim.y * gridDim.z;
    unsigned sum, cnt, mine, sp = 0u;
    for (;;) {
        sum = 0u; cnt = 0u; mine = 0u;
#pragma unroll
        for (unsigned j = 0; j < 16; ++j) { const unsigned c = xb_ld(&bar[XB_XCNT(j)]); sum += c; cnt += (c > 0u) ? 1u : 0u; mine = (j == x) ? c : mine; }
        if (sum == G) break;
        __builtin_amdgcn_s_sleep(1);
        if ((++sp & 255u) == 0u) { if (xb_ld(&bar[XB_TMO])) break; if (sp > XB_SPIN_CAP) { atomicAdd(&bar[XB_TMO], 1u); break; } }
    }
    nloc = mine > 0u ? mine : 1u; nx = cnt > 0u ? cnt : 1u;
}
__device__ __forceinline__ void xcd_barrier(const XcdBarrier& b) {
    asm volatile("s_waitcnt vmcnt(0)" ::: "memory");
    __syncthreads();
    if (threadIdx.x == 0) {
        unsigned* bar = b.bar;
        __builtin_amdgcn_s_waitcnt(0);
        unsigned nloc = b.st[0], nx = b.st[1];
        if (nloc == 0u) { xcd_barrier_complete(bar, b.x, nloc, nx); b.st[0] = nloc; b.st[1] = nx; }
        const unsigned old = xb_add(&bar[XB_XSUB(b.x)], 1u);
        const unsigned gen = old / nloc;
        if (old + 1u == (gen + 1u) * nloc) {
            __builtin_amdgcn_fence(__ATOMIC_RELEASE, "agent");
            asm volatile("s_waitcnt vmcnt(0)" ::: "memory");
            const unsigned og = xb_add(&bar[XB_TOP], 1u);
            const unsigned tg = og / nx;
            if (og + 1u == (tg + 1u) * nx) xb_add(&bar[XB_TOPGEN], 1u);
            else XB_SPIN(xb_ld(&bar[XB_TOPGEN]) == tg, bar);
            __builtin_amdgcn_fence(__ATOMIC_ACQUIRE, "agent");
            xb_add(&bar[XB_XGEN(b.x)], 1u);
            asm volatile("s_waitcnt vmcnt(0)" ::: "memory");
        } else {
            XB_SPIN(xb_ld(&bar[XB_XGEN(b.x)]) == gen, bar);
            __builtin_amdgcn_fence(__ATOMIC_ACQUIRE, "agent");
            asm volatile("s_waitcnt vmcnt(0)" ::: "memory");
        }
    }
    __syncthreads();
}

__global__ void __launch_bounds__(NTHREADS) fwd_kernel(Params P) {
    extern __shared__ __attribute__((aligned(16))) unsigned char lds_raw[];
    LAS unsigned char* lds = (LAS unsigned char*)lds_raw;
    const int G = gridDim.x, c = blockIdx.x;
    const int lo = P.lo, hi = P.hi;
#define IN(k) (lo <= (k) && (k) < hi)
#define REP(k) for (int rep_ = 0; rep_ < ((k) == DUP_PHASE ? 2 : 1); ++rep_)
#define SEAM(k) do { if (IN(k) && IN((k) + 1)) { if ((k) == 0) { cg::this_grid().sync(); bar = xcd_barrier_post((unsigned*)P.ws, bst); } else xcd_barrier(bar); } } while (0)
    volatile LAS unsigned* bst = (volatile LAS unsigned*)(lds + 139264);
    if (threadIdx.x < 2) bst[threadIdx.x] = 0u;
    if (c == 0 && N_LAUNCH == 1) for (int i = threadIdx.x; i < 4096; i += NTHREADS) ((unsigned*)P.ws)[i] = 0u;
    __syncthreads();
    XcdBarrier bar; bar.bar = (unsigned*)P.ws; bar.x = 0; bar.st = bst;
    bf16_t* H = (bf16_t*)(P.ws + WS_H); bf16_t* MIX = (bf16_t*)(P.ws + WS_MIX); const float* mods = (const float*)(P.ws + WS_MODS);
    if (IN(0)) REP(0) phase0(P, lds, G, c);
    SEAM(0);
    if (IN(1)) REP(1) norm_phase<0>(P, G, c);
    SEAM(1);
    if (IN(2)) REP(2) {
        pg8::Gemm g{H, (const bf16_t*)(P.ws + WS_WIN), MT, NINP, D, D, D, 0, 30, 0}; pg8::StaticOrder S; S.init(MT, NINP, G, c);
        EpiIn E{(bf16_t*)(P.ws + WS_QB), (bf16_t*)(P.ws + WS_QIB), (bf16_t*)(P.ws + WS_KP), (bf16_t*)(P.ws + WS_VP), (bf16_t*)(P.ws + WS_KS), (bf16_t*)(P.ws + WS_VS),
                (bf16_t*)(P.ws + WS_KIP), (bf16_t*)(P.ws + WS_KIS), (bf16_t*)(P.ws + WS_U), (float*)(P.ws + WS_WI), P.out};
        pg8::gemm_phase<EpiIn, false>(lds, g, S, E);
    }
    SEAM(2);
    if (IN(3)) { REP(3) idx_phase(P, lds, G, c); z_phase(P, G, c); }
    SEAM(3);
    if (IN(4)) {
        REP(4) attn_phase(P, lds, G, c);
        pg8::Gemm g{(const bf16_t*)(P.ws + WS_Z), (const bf16_t*)(P.ws + WS_WPOOL), MT, 1024, 256, 1024, 256, 512, 30, 0}; pg8::StaticOrder S; S.init(MT, 1024, G, c);
        EpiPool E{MIX, P.pscale};
        pg8::gemm_phase(lds, g, S, E);
    }
    SEAM(4);
    if (IN(5)) REP(5) {
        pg8::Gemm g{MIX, (const bf16_t*)(P.ws + WS_WOUT), TP, D, D, D, D, 0, 30, 0}; pg8::StaticOrder S; S.init(TP, D, G, c);
        EpiRes<0> E{P.xp, P.xs, mods, P.out};
        pg8::gemm_phase(lds, g, S, E);
        pg8::Gemm g2{MIX + (size_t)TP * D, (const bf16_t*)(P.ws + WS_WOUT), TS, D * 8, 256, D, D, 0, 3, 512}; pg8::StaticOrder S2; S2.init(TS, D * 8, G, c);
        EpiPart E2{(float*)(P.ws + WS_PART1)};
        pg8::gemm_phase(lds, g2, S2, E2);
    }
    SEAM(5);
    if (IN(6)) REP(6) norm_phase<1>(P, G, c);
    SEAM(6);
    if (IN(7)) REP(7) {
        pg8::Gemm g{H, (const bf16_t*)(P.ws + WS_WGU), MT, 2 * DFF, D, D, D, 0, 30, 0}; pg8::StaticOrder S; S.init(MT, 2 * DFF, G, c);
        EpiGU E{(bf16_t*)(P.ws + WS_ACT)};
        pg8::gemm_phase(lds, g, S, E);
    }
    SEAM(7);
    if (IN(8)) {
        pg8::Gemm g{(const bf16_t*)(P.ws + WS_ACT), (const bf16_t*)(P.ws + WS_WDN), TP, D, DFF, DFF, DFF, 0, 30, 0}; pg8::StaticOrder S; S.init(TP, D, G, c);
        EpiRes<1> E{P.xp, P.xs, mods, P.out};
        pg8::gemm_phase(lds, g, S, E);
        pg8::Gemm g2{(const bf16_t*)(P.ws + WS_ACT) + (size_t)TP * DFF, (const bf16_t*)(P.ws + WS_WDN), TS, D * 11, 512, DFF, DFF, 0, 3, 1024}; pg8::StaticOrder S2; S2.init(TS, D * 11, G, c);
        EpiPart E2{(float*)(P.ws + WS_PART2)};
        pg8::gemm_phase(lds, g2, S2, E2);
    }
    SEAM(8);
    if (IN(9)) norm_phase<2>(P, G, c);
#if IDX_SELFCHECK
    if (IN(9) && c == 0 && threadIdx.x == 0) { asm volatile("s_waitcnt vmcnt(0)" ::: "memory"); if (__hip_atomic_load((unsigned*)P.ws + 4000, __ATOMIC_RELAXED, __HIP_MEMORY_SCOPE_AGENT) != 0u) P.out[0] = __builtin_nanf(""); }
#endif
#undef IN
#undef SEAM
}

extern "C" void kernel_launch(void* const* d_in, const int* in_sizes, int n_in, void* d_out, int out_size, void* d_ws, size_t ws_size, hipStream_t stream) {
    static int grid = 0;
    if (grid == 0) {
        if (n_in != 20 || (size_t)out_size != O_END || ws_size < WS_END) { fprintf(stderr, "kernel_launch: unexpected shapes (n_in %d, out %d, ws %zu)\n", n_in, out_size, ws_size); grid = -1; return; }
        int dev = 0, cus = 0, per_cu = 0;
        hipGetDevice(&dev); hipDeviceGetAttribute(&cus, hipDeviceAttributeMultiprocessorCount, dev);
        if (hipFuncSetAttribute((const void*)fwd_kernel, hipFuncAttributeMaxDynamicSharedMemorySize, LDS_BYTES) != hipSuccess) { fprintf(stderr, "kernel_launch: hipFuncSetAttribute failed\n"); grid = -1; return; }
        if (hipOccupancyMaxActiveBlocksPerMultiprocessor(&per_cu, (const void*)fwd_kernel, NTHREADS, LDS_BYTES) != hipSuccess || per_cu < 1) { fprintf(stderr, "kernel_launch: occupancy query says %d blocks per CU\n", per_cu); per_cu = 1; }
        (void)hipGetLastError();
        grid = cus * per_cu; if (grid > 256) grid = 256;
    }
    if (grid < 0) return;
    Params p{};
    const float** pp = (const float**)&p;
    for (int i = 0; i < 20; ++i) pp[i] = (const float*)d_in[i];
    p.out = (float*)d_out; p.ws = (unsigned char*)d_ws;
    if (N_LAUNCH == 1) {
        p.lo = 0; p.hi = 10;
        void* args[] = {&p};
        hipError_t e = hipLaunchCooperativeKernel((const void*)fwd_kernel, dim3(grid), dim3(NTHREADS), args, LDS_BYTES, stream);
        if (e != hipSuccess) fprintf(stderr, "cooperative launch failed: %s (grid %d)\n", hipGetErrorString(e), grid);
    } else {
        for (int k = 0; k < 10; ++k) { p.lo = k; p.hi = k + 1; hipLaunchKernelGGL(fwd_kernel, dim3(grid), dim3(NTHREADS), LDS_BYTES, stream, p); }
    }
}
```
